# Optimizing an MI355X kernel written in HIP

```python
import jax
import jax.numpy as jnp
from jax import lax
import numpy as np


D_MODEL = 1024
BATCH = 16
SEQ = 2048
DEPTH = 4

N_MIXERS = 2
N_MLA_LAYERS = (DEPTH + N_MIXERS - 1) // N_MIXERS
N_MLSTM_LAYERS = DEPTH // N_MIXERS

MLA_HEADS = D_MODEL // 128
MLA_NOPE_DIM = 128
MLA_ROPE_DIM = 64
MLA_V_DIM = 128
MLA_Q_RANK = 3 * D_MODEL // 8
MLA_KV_RANK = D_MODEL // 4
ROPE_BASE = 10000.0
Q_BLOCK = 128

MLSTM_HEADS = 4
MLSTM_V_DIM = D_MODEL // MLSTM_HEADS
MLSTM_QK_DIM = MLSTM_V_DIM // 2
MLSTM_CHUNK = 64

N_MEM = 256
MEM_HEADS = 4
MEM_HEAD_DIM = D_MODEL // MEM_HEADS

D_FF = -(-8 * D_MODEL // (3 * 256)) * 256

NORM_EPS = 1e-6

kernel_name = 'hybrid_mla_mlstm_memory_block'


def rmsnorm(x, g):
    xf = x.astype(jnp.float32)
    y = xf * lax.rsqrt(jnp.mean(xf * xf, axis=-1, keepdims=True) + NORM_EPS)
    return (y * g.astype(jnp.float32)).astype(x.dtype)


def rope_tables(positions):
    inv_freq = ROPE_BASE ** (-jnp.arange(0, MLA_ROPE_DIM, 2, dtype=jnp.float32) / MLA_ROPE_DIM)
    ang = positions.astype(jnp.float32)[..., None] * inv_freq
    return jnp.cos(ang), jnp.sin(ang)


def apply_rope(x, cos, sin):
    half = x.shape[-1] // 2
    x1, x2 = x[..., :half], x[..., half:]
    return jnp.concatenate([x1 * cos - x2 * sin, x2 * cos + x1 * sin], axis=-1).astype(x.dtype)


def mla_mixer(h, cos, sin, w_in, q_norm, w_uq, kv_norm, w_ukv, w_o):
    B, S, _ = h.shape
    H = MLA_HEADS
    proj = h @ w_in
    cq, ckv, k_rope = jnp.split(proj, [MLA_Q_RANK, MLA_Q_RANK + MLA_KV_RANK], axis=-1)
    q = (rmsnorm(cq, q_norm) @ w_uq).reshape(B, S, H, MLA_NOPE_DIM + MLA_ROPE_DIM)
    q_nope = q[..., :MLA_NOPE_DIM]
    q_rope = apply_rope(q[..., MLA_NOPE_DIM:], cos[:, :, None, :], sin[:, :, None, :])
    kv = (rmsnorm(ckv, kv_norm) @ w_ukv).reshape(B, S, H, MLA_NOPE_DIM + MLA_V_DIM)
    k_nope, v = kv[..., :MLA_NOPE_DIM], kv[..., MLA_NOPE_DIM:]
    k_rope = apply_rope(k_rope, cos, sin)
    scale = (MLA_NOPE_DIM + MLA_ROPE_DIM) ** -0.5
    nb = S // Q_BLOCK
    key_idx = jnp.arange(S)

    def to_blocks(t):
        return t.reshape(B, nb, Q_BLOCK, *t.shape[2:]).swapaxes(0, 1)

    def attend(args):
        qn, qr, q_idx = args
        s = (jnp.einsum('bqhd,bkhd->bhqk', qn, k_nope)
             + jnp.einsum('bqhr,bkr->bhqk', qr, k_rope)).astype(jnp.float32) * scale
        s = jnp.where(key_idx[None, :] <= q_idx[:, None], s, -jnp.inf)
        p = jax.nn.softmax(s, axis=-1).astype(v.dtype)
        return jnp.einsum('bhqk,bkhd->bqhd', p, v)

    o = lax.map(attend, (to_blocks(q_nope), to_blocks(q_rope), key_idx.reshape(nb, Q_BLOCK)))
    o = o.swapaxes(0, 1).reshape(B, S, H * MLA_V_DIM)
    return o @ w_o


def mlstm_mixer(h, w_in, b_gates, head_norm, w_o):
    B, S, _ = h.shape
    H, DK, DV, L = MLSTM_HEADS, MLSTM_QK_DIM, MLSTM_V_DIM, MLSTM_CHUNK
    f32 = jnp.float32
    proj = h @ w_in
    q, k, v, o_pre, gates = jnp.split(
        proj, [H * DK, 2 * H * DK, 2 * H * DK + H * DV, 2 * H * DK + 2 * H * DV], axis=-1)
    gates = gates.astype(f32) + b_gates.astype(f32)
    log_i = gates[..., :H]
    log_f = jax.nn.log_sigmoid(gates[..., H:])
    q = q.astype(f32).reshape(B, S, H, DK) * DK ** -0.5
    k = k.astype(f32).reshape(B, S, H, DK)
    v = v.astype(f32).reshape(B, S, H, DV)
    nc = S // L

    def chunk_vec(t):
        return t.reshape(B, nc, L, H, t.shape[-1]).transpose(1, 0, 3, 2, 4)

    def chunk_gate(t):
        return t.reshape(B, nc, L, H).transpose(1, 0, 3, 2)

    causal = jnp.tril(jnp.ones((L, L), dtype=bool))

    def step(carry, xs):
        C, n, m = carry
        qc, kc, vc, lic, lfc = xs
        b = jnp.cumsum(lfc, axis=-1)
        d_mat = jnp.where(causal, b[..., :, None] - b[..., None, :] + lic[..., None, :], -jnp.inf)
        g = b + m[..., None]
        mt = jnp.maximum(g, jnp.max(d_mat, axis=-1))
        w_intra = jnp.exp(d_mat - mt[..., None])
        w_inter = jnp.exp(g - mt)
        s = jnp.einsum('bhtd,bhsd->bhts', qc, kc) * w_intra
        num = (w_inter[..., None] * jnp.einsum('bhvd,bhtd->bhtv', C, qc)
               + jnp.einsum('bhts,bhsv->bhtv', s, vc))
        den = w_inter * jnp.einsum('bhd,bhtd->bht', n, qc) + jnp.sum(s, axis=-1)
        hc = num / jnp.maximum(jnp.abs(den), jnp.exp(-mt))[..., None]
        b_last = b[..., -1]
        m_new = mt[..., -1]
        w_k = jnp.exp(b_last[..., None] - b + lic - m_new[..., None])
        decay = jnp.exp(b_last + m - m_new)
        C = decay[..., None, None] * C + jnp.einsum('bhs,bhsv,bhsd->bhvd', w_k, vc, kc)
        n = decay[..., None] * n + jnp.einsum('bhs,bhsd->bhd', w_k, kc)
        return (C, n, m_new), hc

    init = (jnp.zeros((B, H, DV, DK), f32), jnp.zeros((B, H, DK), f32), jnp.zeros((B, H), f32))
    xs = (chunk_vec(q), chunk_vec(k), chunk_vec(v), chunk_gate(log_i), chunk_gate(log_f))
    _, hs = lax.scan(step, init, xs)
    hs = hs.transpose(1, 0, 3, 2, 4).reshape(B, S, H, DV)
    hs = rmsnorm(hs, head_norm)
    out = jax.nn.sigmoid(o_pre.astype(f32)).reshape(B, S, H, DV) * hs
    return out.reshape(B, S, H * DV).astype(h.dtype) @ w_o


def memory_xattn(h, mem_n, w_q, w_kv, w_o):
    B, S, _ = h.shape
    q = (h @ w_q).reshape(B, S, MEM_HEADS, MEM_HEAD_DIM)
    kv = (mem_n @ w_kv).reshape(B, mem_n.shape[1], 2, MEM_HEADS, MEM_HEAD_DIM)
    k, v = kv[:, :, 0], kv[:, :, 1]
    s = jnp.einsum('bqhd,bkhd->bhqk', q, k).astype(jnp.float32) * MEM_HEAD_DIM ** -0.5
    p = jax.nn.softmax(s, axis=-1).astype(v.dtype)
    o = jnp.einsum('bhqk,bkhd->bqhd', p, v).reshape(B, S, MEM_HEADS * MEM_HEAD_DIM)
    return o @ w_o


def swiglu(h, w_gate_up, w_down):
    gate, up = jnp.split(h @ w_gate_up, 2, axis=-1)
    return (jax.nn.silu(gate) * up) @ w_down


def _dense(key, shape, fan_in):
    return jax.random.normal(key, shape, jnp.float32) * fan_in ** -0.5


def _gain(key, shape):
    return 1.0 + 0.02 * jax.random.normal(key, shape, jnp.float32)


def setup_inputs(seed: int = 0) -> dict:
    key = jax.random.key(seed)
    ks = jax.random.split(key, 32)
    D = D_MODEL
    mla_in_cols = MLA_Q_RANK + MLA_KV_RANK + MLA_ROPE_DIM
    mlstm_in_cols = 2 * MLSTM_HEADS * MLSTM_QK_DIM + 2 * MLSTM_HEADS * MLSTM_V_DIM + 2 * MLSTM_HEADS
    x = jax.random.normal(ks[0], (BATCH, SEQ, D), jnp.float32)
    mem = jax.random.normal(ks[1], (BATCH, N_MEM, D), jnp.float32)
    offsets = jax.random.randint(ks[2], (BATCH, 1), 0, 4096, dtype=jnp.int32)
    positions = offsets + jnp.arange(SEQ, dtype=jnp.int32)[None, :]
    b_input = 0.1 * jax.random.normal(ks[3], (N_MLSTM_LAYERS, MLSTM_HEADS), jnp.float32)
    b_forget = (jnp.linspace(3.0, 6.0, MLSTM_HEADS, dtype=jnp.float32)[None, :]
                + 0.1 * jax.random.normal(ks[4], (N_MLSTM_LAYERS, MLSTM_HEADS), jnp.float32))
    return {
        'x': x,
        'mem': mem,
        'positions': positions,
        'mla_w_in': _dense(ks[5], (N_MLA_LAYERS, D, mla_in_cols), D),
        'mla_q_norm': _gain(ks[6], (N_MLA_LAYERS, MLA_Q_RANK)),
        'mla_w_uq': _dense(ks[7], (N_MLA_LAYERS, MLA_Q_RANK, MLA_HEADS * (MLA_NOPE_DIM + MLA_ROPE_DIM)), MLA_Q_RANK),
        'mla_kv_norm': _gain(ks[8], (N_MLA_LAYERS, MLA_KV_RANK)),
        'mla_w_ukv': _dense(ks[9], (N_MLA_LAYERS, MLA_KV_RANK, MLA_HEADS * (MLA_NOPE_DIM + MLA_V_DIM)), MLA_KV_RANK),
        'mla_w_o': _dense(ks[10], (N_MLA_LAYERS, MLA_HEADS * MLA_V_DIM, D), MLA_HEADS * MLA_V_DIM),
        'mlstm_w_in': _dense(ks[11], (N_MLSTM_LAYERS, D, mlstm_in_cols), D),
        'mlstm_b_gates': jnp.concatenate([b_input, b_forget], axis=-1),
        'mlstm_head_norm': _gain(ks[12], (N_MLSTM_LAYERS, MLSTM_HEADS, MLSTM_V_DIM)),
        'mlstm_w_o': _dense(ks[13], (N_MLSTM_LAYERS, MLSTM_HEADS * MLSTM_V_DIM, D), MLSTM_HEADS * MLSTM_V_DIM),
        'norm_mix_pre': _gain(ks[14], (DEPTH, D)),
        'norm_mix_post': _gain(ks[15], (DEPTH, D)),
        'norm_mem_q': _gain(ks[16], (DEPTH, D)),
        'norm_mem_kv': _gain(ks[17], (DEPTH, D)),
        'norm_mem_post': _gain(ks[18], (DEPTH, D)),
        'norm_ffn_pre': _gain(ks[19], (DEPTH, D)),
        'norm_ffn_post': _gain(ks[20], (DEPTH, D)),
        'mem_w_q': _dense(ks[21], (DEPTH, D, MEM_HEADS * MEM_HEAD_DIM), D),
        'mem_w_kv': _dense(ks[22], (DEPTH, D, 2 * MEM_HEADS * MEM_HEAD_DIM), D),
        'mem_w_o': _dense(ks[23], (DEPTH, MEM_HEADS * MEM_HEAD_DIM, D), MEM_HEADS * MEM_HEAD_DIM),
        'ffn_w_gate_up': _dense(ks[24], (DEPTH, D, 2 * D_FF), D),
        'ffn_w_down': _dense(ks[25], (DEPTH, D_FF, D), D_FF),
    }


def reference(x, mem, positions, mla_w_in, mla_q_norm, mla_w_uq, mla_kv_norm, mla_w_ukv, mla_w_o,
              mlstm_w_in, mlstm_b_gates, mlstm_head_norm, mlstm_w_o,
              norm_mix_pre, norm_mix_post, norm_mem_q, norm_mem_kv, norm_mem_post,
              norm_ffn_pre, norm_ffn_post, mem_w_q, mem_w_kv, mem_w_o, ffn_w_gate_up, ffn_w_down):
    cos, sin = rope_tables(positions)
    for i in range(DEPTH):
        j = i // N_MIXERS
        h = rmsnorm(x, norm_mix_pre[i])
        if i % N_MIXERS == 0:
            h = mla_mixer(h, cos, sin, mla_w_in[j], mla_q_norm[j], mla_w_uq[j],
                          mla_kv_norm[j], mla_w_ukv[j], mla_w_o[j])
        else:
            h = mlstm_mixer(h, mlstm_w_in[j], mlstm_b_gates[j], mlstm_head_norm[j], mlstm_w_o[j])
        x = x + rmsnorm(h, norm_mix_post[i])
        h = memory_xattn(rmsnorm(x, norm_mem_q[i]), rmsnorm(mem, norm_mem_kv[i]),
                         mem_w_q[i], mem_w_kv[i], mem_w_o[i])
        x = x + rmsnorm(h, norm_mem_post[i])
        h = swiglu(rmsnorm(x, norm_ffn_pre[i]), ffn_w_gate_up[i], ffn_w_down[i])
        x = x + rmsnorm(h, norm_ffn_post[i])
    return x
```

```cpp
#include <hip/hip_runtime.h>
#include <cstdio>
#include <cstdint>
namespace pg8 {
#define PG8_LAS __attribute__((address_space(3)))
typedef unsigned short bf16_t;
typedef short bf16x8 __attribute__((ext_vector_type(8)));
typedef float f32x4 __attribute__((ext_vector_type(4)));
typedef unsigned u32x4 __attribute__((ext_vector_type(4)));
constexpr int BM = 256, BK = 64, HALF = 128, HTB = HALF * BK * 2  , STAGE_BYTES = 8 * HTB, NXCD = 8, WGM = 8;

__host__ __device__ __forceinline__ int lds_byte(int r, int c) { const int st = (r >> 4) * 2 + (c >> 5), rr = r & 15, cc = c & 31, ob = rr * 64 + cc * 2; return st * 1024 + (ob ^ (((ob >> 9) & 1) << 5)); }
__host__ __device__ __forceinline__ void stage_rc(int b, int& R, int& C) { const int st = b / 1024, sb = b % 1024, swz = sb ^ (((sb >> 9) & 1) << 5); R = (st >> 1) * 16 + swz / 64; C = (st & 1) * 32 + (swz % 64) / 2; }
__host__ __device__ __forceinline__ int perm32(int rho) { const int n = rho >> 4, i = rho & 15; return 8 * (i >> 2) + 4 * n + (i & 3); }

struct Unit { int pm, pn; };
struct Gemm { const bf16_t* A; const bf16_t* Bt; int M, N, K; };

struct StaticOrder {
    int nM, nN, nwg, G, c;
    __host__ __device__ void init(int M, int N, int G_, int c_) { nM = M / BM; nN = N / BM; nwg = nM * nN; G = G_; c = c_; }
    __host__ __device__ bool next(int i, Unit& u) const {
        const long L = (long)i * G + c; if (L >= nwg) return false;
        int wgid = (int)L; { const int q = nwg / NXCD, r = nwg % NXCD, xcd = wgid % NXCD, off = wgid / NXCD; wgid = (xcd < r ? xcd * (q + 1) : r * (q + 1) + (xcd - r) * q) + off; }
        const int nig = WGM * nN, gid = wgid / nig, fm = gid * WGM, gsz = (nM - fm) < WGM ? (nM - fm) : WGM;
        u.pm = fm + ((wgid % nig) % gsz); u.pn = (wgid % nig) / gsz; return true;
    }
    __device__ __forceinline__ void a_ready(const Unit&) const {}
    __device__ __forceinline__ void done(const Unit&) const {}
};

__device__ __forceinline__ unsigned cvt_pk_bf16(float lo, float hi) { unsigned r; asm volatile("v_cvt_pk_bf16_f32 %0, %1, %2" : "=v"(r) : "v"(lo), "v"(hi)); return r; }
typedef float f32x2 __attribute__((ext_vector_type(2)));
__device__ __forceinline__ u32x4 pack8(f32x4 a, f32x4 b) { u32x4 w; w.x = cvt_pk_bf16(a[0], a[1]); w.y = cvt_pk_bf16(a[2], a[3]); w.z = cvt_pk_bf16(b[0], b[1]); w.w = cvt_pk_bf16(b[2], b[3]); return w; }
struct EpiPlain {
    static constexpr bool PERM = true, AFTER_DRAIN = false;
    bf16_t* O; size_t ldc; float scale;
    __device__ __forceinline__ void operator()(const f32x4 (&acc)[2][2][4][2], const Unit& u, int wr, int wc, int fr, int fq) const {
        const int row0 = u.pm * BM + wr * 64 + fr, col0 = u.pn * BM + wc * 32 + 8 * fq;
#pragma unroll
        for (int ai = 0; ai < 2; ++ai)
#pragma unroll
            for (int m = 0; m < 4; ++m) { bf16_t* rowp = O + (size_t)(row0 + ai * HALF + m * 16) * ldc + col0;
#pragma unroll
                for (int bj = 0; bj < 2; ++bj) *(u32x4*)(rowp + bj * HALF) = pack8(acc[ai][bj][m][0] * scale, acc[ai][bj][m][1] * scale); }
    }
};
struct EpiQ {
    static constexpr bool PERM = true, AFTER_DRAIN = false;
    bf16_t* QN; bf16_t* QR; const float* cosT; const float* sinT; float scale;
    __device__ __forceinline__ void operator()(const f32x4 (&acc)[2][2][4][2], const Unit& u, int wr, int wc, int fr, int fq) const {
        asm volatile("" : "+v"(fr), "+v"(fq));
        const int row0 = u.pm * BM + wr * 64 + fr;
        if (u.pn < 4) {
            const int col0 = u.pn * BM + wc * 32 + 8 * fq;
#pragma unroll
            for (int ai = 0; ai < 2; ++ai)
#pragma unroll
                for (int m = 0; m < 4; ++m) { bf16_t* rowp = QN + (size_t)(row0 + ai * HALF + m * 16) * 1024 + col0;
#pragma unroll
                    for (int bj = 0; bj < 2; ++bj) *(u32x4*)(rowp + bj * HALF) = pack8(acc[ai][bj][m][0] * scale, acc[ai][bj][m][1] * scale); }
        } else {
            const int head = 4 * (u.pn - 4) + wc, i0 = 8 * fq;
#pragma unroll
            for (int ai = 0; ai < 2; ++ai)
#pragma unroll
                for (int m = 0; m < 4; ++m) { const size_t row = (size_t)(row0 + ai * HALF + m * 16);
                    const f32x4 c0 = *(const f32x4*)(cosT + row * 32 + i0) * scale, c1 = *(const f32x4*)(cosT + row * 32 + i0 + 4) * scale;
                    const f32x4 s0 = *(const f32x4*)(sinT + row * 32 + i0) * scale, s1 = *(const f32x4*)(sinT + row * 32 + i0 + 4) * scale;
                    const f32x4 xa = acc[ai][0][m][0], xb = acc[ai][0][m][1], ya = acc[ai][1][m][0], yb = acc[ai][1][m][1];
                    bf16_t* rp = QR + row * 512 + head * 64 + i0;
                    *(u32x4*)(rp) = pack8(xa * c0 - ya * s0, xb * c1 - yb * s1);
                    *(u32x4*)(rp + 32) = pack8(ya * c0 + xa * s0, yb * c1 + xb * s1); asm volatile("" ::: "memory"); }
        }
    }
};
struct EpiSwiGLU {
    static constexpr bool PERM = true, AFTER_DRAIN = false;
    bf16_t* O; size_t ldc;
    __device__ __forceinline__ void operator()(const f32x4 (&acc)[2][2][4][2], const Unit& u, int wr, int wc, int fr, int fq) const {
        const int row0 = u.pm * BM + wr * 64 + fr, col0 = u.pn * HALF + wc * 32 + 8 * fq;
#pragma unroll
        for (int ai = 0; ai < 2; ++ai)
#pragma unroll
            for (int m = 0; m < 4; ++m) { f32x4 h[2];
#pragma unroll
                for (int n = 0; n < 2; ++n) { const f32x4 g = acc[ai][0][m][n], up = acc[ai][1][m][n];
#pragma unroll
                    for (int j = 0; j < 4; ++j) h[n][j] = g[j] * up[j] * __builtin_amdgcn_rcpf(1.f + __expf(-g[j])); }
                *(u32x4*)(O + (size_t)(row0 + ai * HALF + m * 16) * ldc + col0) = pack8(h[0], h[1]); }
    }
};
struct EpiQKO {
    static constexpr bool PERM = true, AFTER_DRAIN = false;
    bf16_t* QK; bf16_t* OG; float qscale;
    __device__ __forceinline__ void operator()(const f32x4 (&acc)[2][2][4][2], const Unit& u, int wr, int wc, int fr, int fq) const {
        const int row0 = u.pm * BM + wr * 64 + fr; const bool gate = u.pn >= 4;
        bf16_t* base = gate ? OG : QK; const int col0 = (gate ? u.pn - 4 : u.pn) * BM + wc * 32 + 8 * fq; const float sc = u.pn < 2 ? qscale : 1.f;
#pragma unroll
        for (int ai = 0; ai < 2; ++ai)
#pragma unroll
            for (int m = 0; m < 4; ++m) { bf16_t* rowp = base + (size_t)(row0 + ai * HALF + m * 16) * 1024 + col0;
#pragma unroll
                for (int bj = 0; bj < 2; ++bj) { f32x4 v0 = acc[ai][bj][m][0] * sc, v1 = acc[ai][bj][m][1] * sc;
                    if (gate) {
#pragma unroll
                        for (int j = 0; j < 4; ++j) { v0[j] = __builtin_amdgcn_rcpf(1.f + __expf(-v0[j])); v1[j] = __builtin_amdgcn_rcpf(1.f + __expf(-v1[j])); } }
                    *(u32x4*)(rowp + bj * HALF) = pack8(v0, v1); } }
    }
};

template <class Epi, class Sched, bool ALIGN_EPI = false, bool SP2 = false>
__device__ __forceinline__ void gemm_phase(PG8_LAS unsigned char* lds, const Gemm g, const Sched& S, const Epi& E) {
    int tid_l = threadIdx.x; asm volatile("" : "+v"(tid_l));
    const int tid = tid_l, wid = __builtin_amdgcn_readfirstlane(tid >> 6), lane = tid & 63, wr = wid >> 2, wc = wid & 3, fr = lane & 15, fq = lane >> 4;
    const int K = g.K, nt = K / BK;
    unsigned voffA[2], voffB[2];
#pragma unroll
    for (int i = 0; i < 2; ++i) { int R, C; stage_rc(tid * 16 + i * 8192, R, C); const int Rb = Epi::PERM ? ((R & ~31) + perm32(R & 31)) : R;
        voffA[i] = (unsigned)(R * K + C) * 2u; voffB[i] = (unsigned)(Rb * K + C) * 2u; }
    const size_t kstep = (size_t)(BK * 2);
    const size_t hstep = (size_t)HALF * K * 2;
    const size_t tstep = 2 * hstep;
    const unsigned ldsw = (unsigned)wid * 1024u;
    const int aoff = lds_byte(wr * 64 + fr, fq * 8), boff = lds_byte(wc * 32 + fr, fq * 8);
#define PG8_SA(b, h) (((b) * 2 + (h)) * HTB)
#define PG8_SB(b, h) ((4 + (b) * 2 + (h)) * HTB)
#define PG8_STAGE(bufoff, gbase, voff) do { _Pragma("unroll") for (int _i = 0; _i < 2; ++_i) \
        __builtin_amdgcn_global_load_lds((const unsigned*)((const char*)(gbase) + (voff)[_i]), (PG8_LAS unsigned*)(lds + (bufoff) + ldsw + _i * 8192), 16, 0, 0); } while (0)
#define PG8_LDA(dst, b, h) do { _Pragma("unroll") for (int m = 0; m < 4; ++m) _Pragma("unroll") for (int k = 0; k < 2; ++k) dst[m][k] = *(const PG8_LAS bf16x8*)(lds + PG8_SA(b, h) + aoff + m * 2048 + k * 1024); } while (0)
#define PG8_LDB(dst, b, h) do { _Pragma("unroll") for (int n = 0; n < 2; ++n) _Pragma("unroll") for (int k = 0; k < 2; ++k) dst[n][k] = *(const PG8_LAS bf16x8*)(lds + PG8_SB(b, h) + boff + n * 2048 + k * 1024); } while (0)
#define PG8_MMA(ai, bj, At, Bt) do { __builtin_amdgcn_s_setprio(1); _Pragma("unroll") for (int m = 0; m < 4; ++m) _Pragma("unroll") for (int n = 0; n < 2; ++n) _Pragma("unroll") for (int k = 0; k < 2; ++k) \
        acc[ai][bj][m][n] = __builtin_amdgcn_mfma_f32_16x16x32_bf16(Bt[n][k], At[m][k], acc[ai][bj][m][n], 0, 0, 0); __builtin_amdgcn_s_setprio(0); } while (0)
#define PG8_WAIT_V(n) asm volatile("s_waitcnt vmcnt(" #n ")" ::: "memory")
#define PG8_WAIT_L(n) asm volatile("s_waitcnt lgkmcnt(" #n ")" ::: "memory")
#define PG8_BAR __builtin_amdgcn_s_barrier()
#define PG8_SCHED __builtin_amdgcn_sched_barrier(0)
    Unit cur, nxt; int ui = 0;
    if (!S.next(0, cur)) return;
    f32x4 acc[2][2][4][2];
#pragma unroll
    for (int a = 0; a < 2; ++a)
#pragma unroll
        for (int b = 0; b < 2; ++b)
#pragma unroll
            for (int m = 0; m < 4; ++m)
#pragma unroll
                for (int n = 0; n < 2; ++n) acc[a][b][m][n] = (f32x4){0.f, 0.f, 0.f, 0.f};
    bf16x8 At[4][2], B0[2][2], B1[2][2];
    const char* cA = (const char*)g.A + (size_t)cur.pm * tstep; const char* cB = (const char*)g.Bt + (size_t)cur.pn * tstep;
    S.a_ready(cur);
    if constexpr (SP2) {
        PG8_STAGE(PG8_SB(0, 0), cB, voffB); PG8_STAGE(PG8_SB(0, 1), cB + hstep, voffB); PG8_STAGE(PG8_SA(0, 0), cA, voffA); PG8_STAGE(PG8_SA(0, 1), cA + hstep, voffA);
        if (wr == 1) PG8_BAR;
        PG8_WAIT_V(2); PG8_BAR;
        PG8_STAGE(PG8_SB(1, 0), cB + kstep, voffB); PG8_STAGE(PG8_SA(1, 0), cA + kstep, voffA); PG8_STAGE(PG8_SB(1, 1), cB + hstep + kstep, voffB);
        PG8_WAIT_V(6); PG8_BAR;
    } else {
        PG8_STAGE(PG8_SB(0, 0), cB, voffB); PG8_STAGE(PG8_SA(0, 0), cA, voffA); PG8_STAGE(PG8_SB(0, 1), cB + hstep, voffB); PG8_STAGE(PG8_SA(0, 1), cA + hstep, voffA);
        if (wr == 1) PG8_BAR;
        PG8_WAIT_V(4); PG8_BAR;
        PG8_STAGE(PG8_SB(1, 0), cB + kstep, voffB); PG8_STAGE(PG8_SA(1, 0), cA + kstep, voffA); PG8_STAGE(PG8_SB(1, 1), cB + hstep + kstep, voffB);
        PG8_WAIT_V(6); PG8_BAR;
    }
    for (;;) {
        const bool has_next = S.next(ui + 1, nxt);
        const char* nA = has_next ? (const char*)g.A + (size_t)nxt.pm * tstep : cA; const char* nB = has_next ? (const char*)g.Bt + (size_t)nxt.pn * tstep : cB;
        for (int t = 0; t < nt; t += 2) {
            const bool last = (t == nt - 2);
            const char* a1 = cA + (size_t)(t + 1) * kstep;
            const char* a2 = last ? nA : cA + (size_t)(t + 2) * kstep; const char* b2 = last ? nB : cB + (size_t)(t + 2) * kstep;
            const char* a3 = a2 + kstep; const char* b3 = b2 + kstep;
            if (last && has_next) S.a_ready(nxt);
            if constexpr (SP2) {
            PG8_LDB(B0, 0, 0); PG8_LDB(B1, 0, 1); PG8_SCHED; PG8_LDA(At, 0, 0); PG8_STAGE(PG8_SA(1, 1), a1 + hstep, voffA);
            PG8_WAIT_V(8); PG8_WAIT_L(0); PG8_BAR; PG8_MMA(0, 0, At, B0); PG8_MMA(0, 1, At, B1); PG8_BAR; PG8_SCHED;
            PG8_LDA(At, 0, 1); PG8_STAGE(PG8_SB(0, 0), b2, voffB); PG8_STAGE(PG8_SB(0, 1), b2 + hstep, voffB); PG8_STAGE(PG8_SA(0, 0), a2, voffA);
            PG8_WAIT_V(8); PG8_WAIT_L(0); PG8_BAR; PG8_MMA(1, 0, At, B0); PG8_MMA(1, 1, At, B1); PG8_BAR; PG8_SCHED;
            PG8_LDB(B0, 1, 0); PG8_LDB(B1, 1, 1); PG8_SCHED; PG8_LDA(At, 1, 0); PG8_STAGE(PG8_SA(0, 1), a2 + hstep, voffA);
            PG8_WAIT_V(8); PG8_WAIT_L(0); PG8_BAR; PG8_MMA(0, 0, At, B0); PG8_MMA(0, 1, At, B1); PG8_BAR; PG8_SCHED;
            PG8_LDA(At, 1, 1); PG8_STAGE(PG8_SB(1, 0), b3, voffB); PG8_STAGE(PG8_SB(1, 1), b3 + hstep, voffB); PG8_STAGE(PG8_SA(1, 0), a3, voffA);
            PG8_WAIT_V(8); PG8_WAIT_L(0); PG8_BAR; PG8_MMA(1, 0, At, B0); PG8_MMA(1, 1, At, B1); PG8_BAR; PG8_SCHED;
            } else {
            PG8_LDB(B0, 0, 0); PG8_SCHED; PG8_LDA(At, 0, 0); PG8_STAGE(PG8_SA(1, 1), a1 + hstep, voffA);
            PG8_WAIT_L(8); PG8_BAR; PG8_WAIT_L(0); PG8_MMA(0, 0, At, B0); PG8_BAR; PG8_SCHED;
            PG8_LDB(B1, 0, 1); PG8_STAGE(PG8_SB(0, 0), b2, voffB);
            PG8_BAR; PG8_WAIT_L(0); PG8_MMA(0, 1, At, B1); PG8_BAR;
            PG8_LDA(At, 0, 1); PG8_STAGE(PG8_SA(0, 0), a2, voffA);
            PG8_BAR; PG8_WAIT_L(0); PG8_MMA(1, 0, At, B0); PG8_BAR; PG8_SCHED;
            PG8_STAGE(PG8_SB(0, 1), b2 + hstep, voffB);
            PG8_WAIT_V(6); PG8_BAR; PG8_MMA(1, 1, At, B1); PG8_BAR;
            PG8_LDB(B0, 1, 0); PG8_SCHED; PG8_LDA(At, 1, 0); PG8_STAGE(PG8_SA(0, 1), a2 + hstep, voffA);
            PG8_WAIT_L(8); PG8_BAR; PG8_WAIT_L(0); PG8_MMA(0, 0, At, B0); PG8_BAR; PG8_SCHED;
            PG8_LDB(B1, 1, 1); PG8_STAGE(PG8_SB(1, 0), b3, voffB);
            PG8_BAR; PG8_WAIT_L(0); PG8_MMA(0, 1, At, B1); PG8_BAR;
            PG8_LDA(At, 1, 1); PG8_STAGE(PG8_SA(1, 0), a3, voffA);
            PG8_BAR; PG8_WAIT_L(0); PG8_MMA(1, 0, At, B0); PG8_BAR; PG8_SCHED;
            PG8_STAGE(PG8_SB(1, 1), b3 + hstep, voffB);
            PG8_WAIT_V(6); PG8_BAR; PG8_MMA(1, 1, At, B1); PG8_BAR;
            }
        }
        if constexpr (ALIGN_EPI) { if (wr == 0) PG8_BAR; }
        if constexpr (!Epi::AFTER_DRAIN) { E(acc, cur, wr, wc, fr, fq); S.done(cur); }
        if (!has_next) break;
#pragma unroll
        for (int a = 0; a < 2; ++a)
#pragma unroll
            for (int b = 0; b < 2; ++b)
#pragma unroll
                for (int m = 0; m < 4; ++m)
#pragma unroll
                    for (int n = 0; n < 2; ++n) acc[a][b][m][n] = (f32x4){0.f, 0.f, 0.f, 0.f};
        cur = nxt; cA = nA; cB = nB; ++ui;
        if constexpr (ALIGN_EPI) { if (wr == 1) PG8_BAR; }
    }
    PG8_WAIT_V(0);
    if constexpr (!ALIGN_EPI) { if (wr == 0) PG8_BAR; }
    PG8_BAR;
    if constexpr (Epi::AFTER_DRAIN) { E.fused(acc, cur, wr, wc, fr, fq, lds, wid, lane); S.done(cur); }
#undef PG8_SA
#undef PG8_SB
#undef PG8_STAGE
#undef PG8_LDA
#undef PG8_LDB
#undef PG8_MMA
#undef PG8_WAIT_V
#undef PG8_WAIT_L
#undef PG8_BAR
#undef PG8_SCHED
}
}

constexpr int D = 1024, NB = 16, SEQ = 2048, M = NB * SEQ, DEPTH = 4;
constexpr int NMEM = 256, MMEM = NB * NMEM;
constexpr int DFF = 2816;
constexpr int MLA_H = 8, QRANK = 384, KVRANK = 256, MLA_IN = 704, MLA_INP = 768;
constexpr int LH = 4, LDK = 128, LDV = 256;
constexpr int MLSTM_IN = 3080;
constexpr float EPS = 1e-6f;
constexpr float LOG2E = 1.4426950408889634f;
constexpr float MLA_QS = 0.07216878364870322f * LOG2E;
constexpr float MEM_QS = 0.0625f * LOG2E;
constexpr float LQ_S = 0.08838834764831845f;
constexpr int NWAVES = 8;

constexpr size_t MiB = 1u << 20;
constexpr size_t WS_CTL = 0, CTL_ZERO_BYTES = 1 * MiB;
constexpr size_t WS_COS = 1 * MiB, WS_SIN = 5 * MiB;
constexpr size_t WS_GATES = 9 * MiB;
constexpr size_t WS_W = 16 * MiB;
constexpr size_t WS_KM = 148 * MiB;
constexpr size_t WS_VMT = 180 * MiB;
constexpr size_t WS_HN = 212 * MiB;
constexpr size_t WS_BIG = 276 * MiB;
constexpr size_t WS_END = 512 * MiB;
constexpr size_t WE_MLA_IN = 0, WE_MLA_UQ = WE_MLA_IN + (size_t)MLA_INP * D, WE_MLA_UKV = WE_MLA_UQ + (size_t)1536 * QRANK, WE_MLA_O = WE_MLA_UKV + (size_t)2048 * KVRANK, WE_MLA_SZ = WE_MLA_O + (size_t)D * D;
constexpr size_t WE_L_IN = 0, WE_L_O = (size_t)3584 * D, WE_L_SZ = WE_L_O + (size_t)D * D;
constexpr size_t WE_M_Q = 0, WE_M_KV = (size_t)D * D, WE_M_O = WE_M_KV + (size_t)2048 * D, WE_M_SZ = WE_M_O + (size_t)D * D;
constexpr size_t WE_F_GU = 0, WE_F_D = (size_t)2 * DFF * D, WE_F_SZ = WE_F_D + (size_t)D * DFF;
constexpr size_t WE_MLA = 0, WE_L = WE_MLA + 2 * WE_MLA_SZ, WE_M = WE_L + 2 * WE_L_SZ, WE_F = WE_M + 4 * WE_M_SZ, WE_TOTAL = WE_F + 4 * WE_F_SZ;
static_assert(WS_W + WE_TOTAL * 2 <= WS_KM, "weights fit");
constexpr size_t B_QN = 0, B_QR = 64 * MiB, B_VT = 96 * MiB, B_CQN = 160 * MiB, B_CKVN = 184 * MiB, B_KR = 200 * MiB;
constexpr size_t B_QM = 0, B_MEMN = 0;
constexpr size_t B_HID = 0;
constexpr size_t B_QK = 0, B_OG = 64 * MiB, B_KVT = 128 * MiB;
static_assert(B_KVT + (size_t)1536 * M * 2 <= WS_END - WS_BIG && B_HID + (size_t)M * DFF * 2 <= WS_END - WS_BIG && B_KR + (size_t)M * 64 * 2 <= WS_END - WS_BIG, "BIG map");

constexpr int RING_BYTES = 131072;
constexpr int LDSCTL_OFF = RING_BYTES, MISC_OFF = LDSCTL_OFF + 320;
constexpr int LDS_BYTES = 147456;

#define GAS __attribute__((address_space(1)))
#define LAS __attribute__((address_space(3)))
typedef unsigned short bf16;
typedef unsigned v4u __attribute__((ext_vector_type(4)));
typedef float f32x4 __attribute__((ext_vector_type(4)));
typedef short bf16x8 __attribute__((ext_vector_type(8)));
typedef GAS unsigned gu32;
typedef GAS unsigned long long gu64;
#define RLX_AGENT __ATOMIC_RELAXED, __HIP_MEMORY_SCOPE_AGENT
#define LDS_WAIT() asm volatile("s_waitcnt lgkmcnt(0)" ::: "memory")
#define VM_WAIT() asm volatile("s_waitcnt vmcnt(0)" ::: "memory")
__device__ __forceinline__ unsigned long long rt() { return __builtin_amdgcn_s_memrealtime(); }
__device__ __forceinline__ unsigned f2bf(float f) { unsigned u = __builtin_bit_cast(unsigned, f); return (u + 0x7fffu + ((u >> 16) & 1u)) >> 16; }
__device__ __forceinline__ unsigned pk2(float lo, float hi) { return f2bf(lo) | (f2bf(hi) << 16); }

#define XB_TMO      128
#define XB_XCNT(j)  (256  + 64 * (j))
#define XB_XSUB(j)  (1280 + 64 * (j))
#define XB_XGEN(j)  (2304 + 64 * (j))
#define XB_TOP      3328
#define XB_TOPGEN   3392
#define XCD_BAR_WORDS 3456
#define XB_SPIN_CAP (1u << 18)

__device__ __forceinline__ unsigned xb_ld(unsigned* p)              { return __hip_atomic_load(p, __ATOMIC_RELAXED, __HIP_MEMORY_SCOPE_AGENT); }
__device__ __forceinline__ unsigned xb_add(unsigned* p, unsigned v) { return __hip_atomic_fetch_add(p, v, __ATOMIC_RELAXED, __HIP_MEMORY_SCOPE_AGENT); }
__device__ __forceinline__ unsigned xb_xcc_id() { return (unsigned)__builtin_amdgcn_s_getreg((3 << 11) | 20) & 0xFu; }
#define XB_SPIN(cond, bar) do { unsigned _sp = 0; while (cond) { __builtin_amdgcn_s_sleep(1); \
    if ((++_sp & 255u) == 0u) { if (xb_ld(&(bar)[XB_TMO])) break; if (_sp > XB_SPIN_CAP) { atomicAdd(&(bar)[XB_TMO], 1u); break; } } } } while (0)

struct XcdBarrier {
    unsigned* bar; unsigned x;
    volatile LAS unsigned* st;
};

__device__ __forceinline__ XcdBarrier xcd_barrier_post(unsigned* bar, volatile LAS unsigned* st) {
    XcdBarrier b; b.bar = bar; b.x = xb_xcc_id(); b.st = st;
    if (threadIdx.x == 0) (void)xb_add(&bar[XB_XCNT(b.x)], 1u);
    return b;
}
__device__ __forceinline__ void xcd_barrier_complete(unsigned* bar, unsigned x, unsigned& nloc, unsigned& nx) {
    const unsigned G = gridDim.x * gridDim.y * gridDim.z;
    unsigned sum, cnt, mine, sp = 0u;
    for (;;) {
        sum = 0u; cnt = 0u; mine = 0u;
#pragma unroll
        for (unsigned j = 0; j < 16; ++j) { const unsigned c = xb_ld(&bar[XB_XCNT(j)]); sum += c; cnt += (c > 0u) ? 1u : 0u; mine = (j == x) ? c : mine; }
        if (sum == G) break;
        __builtin_amdgcn_s_sleep(1);
        if ((++sp & 255u) == 0u) { if (xb_ld(&bar[XB_TMO])) break; if (sp > XB_SPIN_CAP) { atomicAdd(&bar[XB_TMO], 1u); break; } }
    }
    nloc = mine > 0u ? mine : 1u; nx = cnt > 0u ? cnt : 1u;
}

__device__ __forceinline__ void xcd_barrier(const XcdBarrier& b) {
    asm volatile("s_waitcnt vmcnt(0)" ::: "memory");
    __syncthreads();
    if (threadIdx.x == 0) {
        unsigned* bar = b.bar;
        __builtin_amdgcn_s_waitcnt(0);
        unsigned nloc = b.st[0], nx = b.st[1];
        if (nloc == 0u) { xcd_barrier_complete(bar, b.x, nloc, nx); b.st[0] = nloc; b.st[1] = nx; }
        const unsigned old = xb_add(&bar[XB_XSUB(b.x)], 1u);
        const unsigned gen = old / nloc;
        if (old + 1u == (gen + 1u) * nloc) {
            __builtin_amdgcn_fence(__ATOMIC_RELEASE, "agent");
            asm volatile("s_waitcnt vmcnt(0)" ::: "memory");
            const unsigned og = xb_add(&bar[XB_TOP], 1u);
            const unsigned tg = og / nx;
            if (og + 1u == (tg + 1u) * nx) xb_add(&bar[XB_TOPGEN], 1u);
            else XB_SPIN(xb_ld(&bar[XB_TOPGEN]) == tg, bar);
            __builtin_amdgcn_fence(__ATOMIC_ACQUIRE, "agent");
            xb_add(&bar[XB_XGEN(b.x)], 1u);
            asm volatile("s_waitcnt vmcnt(0)" ::: "memory");
        } else {
            XB_SPIN(xb_ld(&bar[XB_XGEN(b.x)]) == gen, bar);
            __builtin_amdgcn_fence(__ATOMIC_ACQUIRE, "agent");
            asm volatile("s_waitcnt vmcnt(0)" ::: "memory");
        }
    }
    __syncthreads();
}
__device__ __forceinline__ int opq_s(int x) { asm volatile("" : "+s"(x)); return x; }
typedef unsigned u32x4 __attribute__((ext_vector_type(4)));
typedef unsigned u32x2 __attribute__((ext_vector_type(2)));
__device__ __forceinline__ float wave_sum(float v) {
#pragma unroll
    for (int o = 1; o < 64; o <<= 1) v += __shfl_xor(v, o);
    return v;
}
__device__ __forceinline__ float wave_max(float v) {
#pragma unroll
    for (int o = 1; o < 64; o <<= 1) v = fmaxf(v, __shfl_xor(v, o));
    return v;
}
__device__ __forceinline__ float bflo(unsigned w) { return __uint_as_float(w << 16); }
__device__ __forceinline__ float bfhi(unsigned w) { return __uint_as_float(w & 0xffff0000u); }
__device__ __forceinline__ float bf2f(bf16 b) { return __uint_as_float((unsigned)b << 16); }
__device__ __forceinline__ void load_row_f32(const float* p, int lane, f32x4 (&v)[4]) {
#pragma unroll
    for (int j = 0; j < 4; ++j) v[j] = *(const f32x4*)(p + 4 * lane + 256 * j);
}
__device__ __forceinline__ void load_row_bf16(const bf16* p, int lane, f32x4 (&v)[4]) {
#pragma unroll
    for (int j = 0; j < 4; ++j) { const u32x2 w = *(const u32x2*)(p + 4 * lane + 256 * j); v[j] = (f32x4){bflo(w.x), bfhi(w.x), bflo(w.y), bfhi(w.y)}; }
}
__device__ __forceinline__ void store_row_bf16(bf16* p, int lane, const f32x4 (&v)[4]) {
#pragma unroll
    for (int j = 0; j < 4; ++j) { u32x2 w; w.x = pg8::cvt_pk_bf16(v[j][0], v[j][1]); w.y = pg8::cvt_pk_bf16(v[j][2], v[j][3]); *(u32x2*)(p + 4 * lane + 256 * j) = w; }
}
__device__ __forceinline__ float row_ssq(const f32x4 (&v)[4]) {
    float s = 0.f;
#pragma unroll
    for (int j = 0; j < 4; ++j) s += (v[j][0] * v[j][0] + v[j][1] * v[j][1]) + (v[j][2] * v[j][2] + v[j][3] * v[j][3]);
    return wave_sum(s);
}
__device__ __forceinline__ float log_sigmoid(float x) { return fminf(x, 0.f) - log1pf(__expf(-fabsf(x))); }

enum { CK_ID = 0, CK_MLA_IN, CK_MLA_UQ, CK_MLA_UKV, CK_L_IN, CK_F_GU };
__device__ __forceinline__ int src_col(int kind, int n) {
    switch (kind) {
    case CK_MLA_IN: return n < MLA_IN ? n : -1;
    case CK_MLA_UQ: if (n < 1024) return 192 * (n >> 7) + (n & 127);
                    else { const int r = n - 1024, tile = r >> 8, half = (r >> 7) & 1, hl = (r >> 5) & 3; return 192 * (4 * tile + hl) + 128 + 32 * half + (r & 31); }
    case CK_MLA_UKV: if (n < 1024) return 256 * (n >> 7) + (n & 127); else { const int r = n - 1024; return 256 * (r >> 7) + 128 + (r & 127); }
    case CK_L_IN: if (n < 1024) return n; if (n < 2048) return 2048 + (n - 1024); if (n < 2560) return 512 + (n - 2048); return 1024 + (n - 2560);
    case CK_F_GU: { const int pn = n >> 8, half = (n >> 7) & 1; return half * DFF + 128 * pn + (n & 127); }
    default: return n;
    }
}
__device__ __forceinline__ void cvt_item(const float* W, int K, int Nsrc, int sc, bf16* WTrow0, LAS float* scr, int kb, int lane) {
    const int k0 = 64 * kb;
    if (sc >= 0) {
#pragma unroll 8
        for (int i = 0; i < 32; ++i) { const int kk = 2 * i + (lane >> 5); scr[kk * 33 + (lane & 31)] = W[(size_t)(k0 + kk) * Nsrc + sc + (lane & 31)]; }
    } else {
#pragma unroll 8
        for (int i = 0; i < 32; ++i) { const int kk = 2 * i + (lane >> 5); scr[kk * 33 + (lane & 31)] = 0.f; }
    }
    LDS_WAIT(); asm volatile("" ::: "memory");
    const int c = lane & 7;
#pragma unroll
    for (int j = 0; j < 4; ++j) { const int n = (lane >> 3) + 8 * j; const LAS float* s = scr + (8 * c) * 33 + n;
        u32x4 o; o.x = pg8::cvt_pk_bf16(s[0 * 33], s[1 * 33]); o.y = pg8::cvt_pk_bf16(s[2 * 33], s[3 * 33]); o.z = pg8::cvt_pk_bf16(s[4 * 33], s[5 * 33]); o.w = pg8::cvt_pk_bf16(s[6 * 33], s[7 * 33]);
        *(u32x4*)(WTrow0 + (size_t)n * K + k0 + 8 * c) = o; }
    LDS_WAIT(); asm volatile("" ::: "memory");
}

template <int D1, int D2, int DV>
__device__ __forceinline__ void naive_attn_row(const bf16* q1, const bf16* q2, const bf16* k1, size_t k1p, const bf16* k2, size_t k2p, int nk,
                                               const bf16* vt, size_t vtp, bf16* o, LAS float* qs, LAS float* sc, int lane) {
    for (int d = lane; d < D1; d += 64) qs[d] = bf2f(q1[d]);
    if (D2 > 0) for (int d = lane; d < D2; d += 64) qs[D1 + d] = bf2f(q2[d]);
    LDS_WAIT();
    float mx = -1e30f;
    const int nkr = (nk + 63) & ~63;
    for (int kb = 0; kb < nkr; kb += 64) {
        const int key = kb + lane; float s = -__builtin_inff();
        if (key < nk) {
            s = 0.f; const bf16* kr = k1 + (size_t)key * k1p;
            for (int c = 0; c < D1 / 8; ++c) { const u32x4 w = *(const u32x4*)(kr + 8 * c); const LAS float* q = qs + 8 * c;
                s += q[0] * bflo(w.x) + q[1] * bfhi(w.x) + q[2] * bflo(w.y) + q[3] * bfhi(w.y) + q[4] * bflo(w.z) + q[5] * bfhi(w.z) + q[6] * bflo(w.w) + q[7] * bfhi(w.w); }
            if (D2 > 0) { const bf16* kr2 = k2 + (size_t)key * k2p;
                for (int c = 0; c < D2 / 8; ++c) { const u32x4 w = *(const u32x4*)(kr2 + 8 * c); const LAS float* q = qs + D1 + 8 * c;
                    s += q[0] * bflo(w.x) + q[1] * bfhi(w.x) + q[2] * bflo(w.y) + q[3] * bfhi(w.y) + q[4] * bflo(w.z) + q[5] * bfhi(w.z) + q[6] * bflo(w.w) + q[7] * bfhi(w.w); } }
        }
        sc[key] = s; mx = fmaxf(mx, s);
    }
    mx = wave_max(mx);
    float sum = 0.f;
    LDS_WAIT();
    for (int kb = 0; kb < nkr; kb += 64) { const int key = kb + lane; const float p = exp2f(sc[key] - mx); sc[key] = p; sum += p; }
    sum = wave_sum(sum);
    LDS_WAIT();
    const float inv = 1.f / sum;
#pragma unroll
    for (int i = 0; i < DV / 64; ++i) { const int dv = lane + 64 * i; const bf16* vr = vt + (size_t)dv * vtp; float acc = 0.f;
        for (int kb = 0; kb < nkr; kb += 8) { const u32x4 w = *(const u32x4*)(vr + kb); const LAS float* p = sc + kb;
            acc += p[0] * bflo(w.x) + p[1] * bfhi(w.x) + p[2] * bflo(w.y) + p[3] * bfhi(w.y) + p[4] * bflo(w.z) + p[5] * bfhi(w.z) + p[6] * bflo(w.w) + p[7] * bfhi(w.w); }
        o[dv] = (bf16)(pg8::cvt_pk_bf16(acc * inv, 0.f) & 0xffffu); }
    LDS_WAIT();
}

__device__ __forceinline__ void naive_scan_unit(int unit, const bf16* QK, const bf16* KVT, const float* GATES, bf16* HS, LAS unsigned char* lds, int tid) {
    const int b = unit >> 4, h = (unit >> 2) & 3, vs = unit & 3;
    LAS float* ql = (LAS float*)lds; LAS float* kl = ql + 64 * 128; LAS float* vl = kl + 64 * 128; LAS float* gl = vl + 64 * 64;
    const int v = tid >> 3, dg = tid & 7;
    float C[16], n[16];
#pragma unroll
    for (int i = 0; i < 16; ++i) { C[i] = 0.f; n[i] = 0.f; }
    float m = 0.f;
    for (int c = 0; c < SEQ / 64; ++c) {
        const size_t tok0 = (size_t)b * SEQ + (size_t)c * 64;
        __syncthreads();
#pragma unroll
        for (int i = 0; i < 2; ++i) { const int ch = tid + 512 * i, t = ch >> 4, c8 = ch & 15;
            const u32x4 wq = *(const u32x4*)(QK + (tok0 + t) * 1024 + h * 128 + c8 * 8); const u32x4 wk = *(const u32x4*)(QK + (tok0 + t) * 1024 + 512 + h * 128 + c8 * 8);
            LAS float* qd = ql + t * 128 + c8 * 8; LAS float* kd = kl + t * 128 + c8 * 8;
            qd[0] = bflo(wq.x); qd[1] = bfhi(wq.x); qd[2] = bflo(wq.y); qd[3] = bfhi(wq.y); qd[4] = bflo(wq.z); qd[5] = bfhi(wq.z); qd[6] = bflo(wq.w); qd[7] = bfhi(wq.w);
            kd[0] = bflo(wk.x); kd[1] = bfhi(wk.x); kd[2] = bflo(wk.y); kd[3] = bfhi(wk.y); kd[4] = bflo(wk.z); kd[5] = bfhi(wk.z); kd[6] = bflo(wk.w); kd[7] = bfhi(wk.w); }
        { const int row = tid >> 3, t8 = tid & 7; const u32x4 w = *(const u32x4*)(KVT + (size_t)(512 + h * 256 + vs * 64 + row) * M + tok0 + t8 * 8);
            LAS float* vd = vl + (t8 * 8) * 64 + row;
            vd[0 * 64] = bflo(w.x); vd[1 * 64] = bfhi(w.x); vd[2 * 64] = bflo(w.y); vd[3 * 64] = bfhi(w.y); vd[4 * 64] = bflo(w.z); vd[5 * 64] = bfhi(w.z); vd[6 * 64] = bflo(w.w); vd[7 * 64] = bfhi(w.w); }
        if (tid < 64) { gl[2 * tid] = GATES[(tok0 + tid) * 8 + h]; gl[2 * tid + 1] = log_sigmoid(GATES[(tok0 + tid) * 8 + 4 + h]); }
        __syncthreads();
        for (int t = 0; t < 64; ++t) {
            const float li = gl[2 * t], lf = gl[2 * t + 1];
            const float mn = fmaxf(lf + m, li), fw = __expf(lf + m - mn), iw = __expf(li - mn); m = mn;
            const float vv = vl[t * 64 + v] * iw;
            float num = 0.f, den = 0.f;
#pragma unroll
            for (int i = 0; i < 16; ++i) { const float kk = kl[t * 128 + dg + 8 * i], qq = ql[t * 128 + dg + 8 * i];
                C[i] = fw * C[i] + vv * kk; n[i] = fw * n[i] + iw * kk; num += C[i] * qq; den += n[i] * qq; }
            num += __shfl_xor(num, 1); den += __shfl_xor(den, 1); num += __shfl_xor(num, 2); den += __shfl_xor(den, 2); num += __shfl_xor(num, 4); den += __shfl_xor(den, 4);
            if (dg == 0) { const float hv = num / fmaxf(fabsf(den), __expf(-m)); HS[(tok0 + t) * 1024 + h * 256 + vs * 64 + v] = (bf16)(pg8::cvt_pk_bf16(hv, 0.f) & 0xffffu); }
        }
    }
}
#ifndef MK_ONE_LAUNCH
#define MK_ONE_LAUNCH 0
#endif
constexpr int NPH_L = 13, NPHASES = 2 + DEPTH * NPH_L;
struct Args { const void* in[25]; float* out; unsigned char* ws; int lo, hi; };

template <int SITE  >
__global__ void __launch_bounds__(NWAVES * 64, 2) fwd(Args args) {
    extern __shared__ __attribute__((aligned(16))) unsigned char lds_raw[];
    LAS unsigned char* lds = (LAS unsigned char*)lds_raw;
    const int G = gridDim.x, bx = blockIdx.x, NGW = G * NWAVES;
#define PH_REGS int tid = threadIdx.x; asm volatile("" : "+v"(tid)); const int lane = tid & 63, wave = __builtin_amdgcn_readfirstlane(tid >> 6), gw = bx * NWAVES + wave; (void)lane; (void)gw;
    gu32* ctl = (gu32*)(args.ws + WS_CTL);
    volatile LAS unsigned* MISC = (volatile LAS unsigned*)(lds + MISC_OFF);
    { PH_REGS for (int u = tid; u < (LDS_BYTES - LDSCTL_OFF) / 4; u += NWAVES * 64) ((LAS unsigned*)(lds + LDSCTL_OFF))[u] = 0u; }
    __syncthreads();
    XcdBarrier bar; bar.bar = (unsigned*)ctl + 4096; bar.x = 0; bar.st = nullptr;
    if (MK_ONE_LAUNCH) bar = xcd_barrier_post((unsigned*)ctl + 4096, MISC + 8);
    const int lo = args.lo, hi = args.hi;
#define INP(p) (lo <= (p) && (p) < hi)
#define SEL(k) (SITE < 0 || SITE == (k))
#define SEAM(p) do { if (MK_ONE_LAUNCH && (p) + 1 < hi) xcd_barrier(bar); } while (0)

#define PH_PTRS unsigned char* ws = args.ws; asm volatile("" : "+s"(ws)); bf16* W = (bf16*)(ws + WS_W); bf16* HN = (bf16*)(ws + WS_HN); unsigned char* BIG = ws + WS_BIG; \
    float* COS = (float*)(ws + WS_COS); float* SIN = (float*)(ws + WS_SIN); float* GATES = (float*)(ws + WS_GATES); bf16* KM = (bf16*)(ws + WS_KM); bf16* VMT = (bf16*)(ws + WS_VMT); float* X = args.out; \
    (void)W; (void)HN; (void)BIG; (void)COS; (void)SIN; (void)GATES; (void)KM; (void)VMT; (void)X;
#define INF(k) ((const float*)args.in[opq_s(k)])
    if constexpr (SEL(0)) if (INP(0)) { PH_REGS PH_PTRS const float* x_in = INF(0); const float* mem_in = INF(1); const int* pos_in = (const int*)args.in[opq_s(2)];
        LAS float* scr = (LAS float*)(lds + wave * 16384);
        int off = 0;
#define CVT_JOB(src_, K_, Nsrc_, Ndst_, kind_, dst_) do { const int nnb_ = (Ndst_) / 32, items_ = ((K_) / 64) * nnb_; \
        for (int it_ = (gw - off + 2 * NGW) % NGW; it_ < items_; it_ += NGW) { const int kb_ = it_ / nnb_, nb_ = it_ % nnb_; \
            cvt_item((src_), (K_), (Nsrc_), src_col((kind_), nb_ * 32), (dst_) + (size_t)(nb_ * 32) * (K_), scr, kb_, lane); } \
        off = (off + items_) % NGW; } while (0)
        for (int j = 0; j < 2; ++j) {
            bf16* wm = W + WE_MLA + j * WE_MLA_SZ;
            CVT_JOB(INF(3) + (size_t)j * D * MLA_IN, D, MLA_IN, MLA_INP, CK_MLA_IN, wm + WE_MLA_IN);
            CVT_JOB(INF(5) + (size_t)j * QRANK * 1536, QRANK, 1536, 1536, CK_MLA_UQ, wm + WE_MLA_UQ);
            CVT_JOB(INF(7) + (size_t)j * KVRANK * 2048, KVRANK, 2048, 2048, CK_MLA_UKV, wm + WE_MLA_UKV);
            CVT_JOB(INF(8) + (size_t)j * D * D, D, D, D, CK_ID, wm + WE_MLA_O);
            bf16* wl = W + WE_L + j * WE_L_SZ;
            CVT_JOB(INF(9) + (size_t)j * D * MLSTM_IN, D, MLSTM_IN, 3584, CK_L_IN, wl + WE_L_IN);
            CVT_JOB(INF(12) + (size_t)j * D * D, D, D, D, CK_ID, wl + WE_L_O);
        }
        for (int l = 0; l < DEPTH; ++l) {
            bf16* wmm = W + WE_M + l * WE_M_SZ;
            CVT_JOB(INF(20) + (size_t)l * D * D, D, D, D, CK_ID, wmm + WE_M_Q);
            CVT_JOB(INF(21) + (size_t)l * D * 2048, D, 2048, 2048, CK_ID, wmm + WE_M_KV);
            CVT_JOB(INF(22) + (size_t)l * D * D, D, D, D, CK_ID, wmm + WE_M_O);
            bf16* wf = W + WE_F + l * WE_F_SZ;
            CVT_JOB(INF(23) + (size_t)l * D * 2 * DFF, D, 2 * DFF, 2 * DFF, CK_F_GU, wf + WE_F_GU);
            CVT_JOB(INF(24) + (size_t)l * DFF * D, DFF, D, D, CK_ID, wf + WE_F_D);
        }
#undef CVT_JOB
        for (int idx = bx * (NWAVES * 64) + tid; idx < M * 32; idx += G * NWAVES * 64) {
            const int tok = idx >> 5, i = idx & 31;
            double f = 1.0; for (int q = 0; q < i; ++q) f *= 0.7498942093324559;
            const double ang = (double)pos_in[tok] * f;
            const double kq = __builtin_rint(ang * 0.6366197723675814);
            const double r = (ang - kq * 1.5707963267948966) - kq * 6.123233995736766e-17;
            const double r2 = r * r;
            const double sn = r * (1.0 + r2 * (-1.0 / 6 + r2 * (1.0 / 120 + r2 * (-1.0 / 5040 + r2 * (1.0 / 362880 + r2 * (-1.0 / 39916800 + r2 * (1.0 / 6227020800.0)))))));
            const double cs = 1.0 + r2 * (-0.5 + r2 * (1.0 / 24 + r2 * (-1.0 / 720 + r2 * (1.0 / 40320 + r2 * (-1.0 / 3628800 + r2 * (1.0 / 479001600 + r2 * (-1.0 / 87178291200.0)))))));
            const int qd = (int)((long long)kq & 3);
            const double c = (qd == 0) ? cs : (qd == 1) ? -sn : (qd == 2) ? -cs : sn;
            const double s = (qd == 0) ? sn : (qd == 1) ? cs : (qd == 2) ? -sn : -cs;
            COS[idx] = (float)c; SIN[idx] = (float)s;
        }
        { bf16* MEMN = (bf16*)(BIG + B_MEMN); const float* gkv = INF(16);
          for (int r = gw; r < MMEM; r += NGW) { f32x4 v[4]; load_row_f32(mem_in + (size_t)r * D, lane, v); const float rs = rsqrtf(row_ssq(v) * (1.f / D) + EPS);
            for (int l = 0; l < DEPTH; ++l) { f32x4 g[4], o[4]; load_row_f32(gkv + l * D, lane, g);
#pragma unroll
                for (int j = 0; j < 4; ++j) o[j] = v[j] * rs * g[j];
                store_row_bf16(MEMN + ((size_t)l * MMEM + r) * D, lane, o); } } }
        { f32x4 g[4]; load_row_f32(INF(13), lane, g);
          for (int r = gw; r < M; r += NGW) { f32x4 v[4]; load_row_f32(x_in + (size_t)r * D, lane, v); const float rs = rsqrtf(row_ssq(v) * (1.f / D) + EPS);
#pragma unroll
            for (int j = 0; j < 4; ++j) v[j] = v[j] * rs * g[j];
            store_row_bf16(HN + (size_t)r * D, lane, v); } }
        SEAM(0);
    }
    if constexpr (SEL(1)) if (INP(1)) { PH_PTRS
        const int l = bx >> 6, c = bx & 63; const bf16* MEMN = (const bf16*)(BIG + B_MEMN) + (size_t)l * MMEM * D; const bf16* wkv = W + WE_M + l * WE_M_SZ + WE_M_KV;
        if (G == 256) {
            { pg8::Gemm g{MEMN, wkv, MMEM, D, D}; pg8::StaticOrder S; S.init(MMEM, D, 64, c); pg8::EpiPlain E{KM + (size_t)l * MMEM * D, (size_t)D, 1.f};
              pg8::gemm_phase<pg8::EpiPlain, pg8::StaticOrder, true, true>(lds, g, S, E); }
            { pg8::Gemm g{wkv + (size_t)D * D, MEMN, D, MMEM, D}; pg8::StaticOrder S; S.init(D, MMEM, 64, c); pg8::EpiPlain E{VMT + (size_t)l * D * MMEM, (size_t)MMEM, 1.f};
              pg8::gemm_phase<pg8::EpiPlain, pg8::StaticOrder, true, true>(lds, g, S, E); }
        }
        SEAM(1);
    }

#define ROW_PASS(xin_, gpost_, gpre_, gw_src_, gb_) do { \
        const float* xin__ = (xin_); const float* gpost__ = (gpost_); const float* gpre__ = (gpre_); const float* gws__ = (gw_src_); const float* gb__ = (gb_); \
        LAS float* wgl = (LAS float*)lds; \
        if (gws__) { for (int i_ = tid; i_ < 8 * D; i_ += NWAVES * 64) { const int k_ = i_ >> 3, g_ = i_ & 7; wgl[g_ * D + k_] = gws__[(size_t)k_ * MLSTM_IN + 3072 + g_]; } __syncthreads(); } \
        f32x4 gp__[4], gq__[4]; load_row_f32(gpost__, lane, gp__); if (gpre__) load_row_f32(gpre__, lane, gq__); \
        for (int r_ = gw; r_ < M; r_ += NGW) { f32x4 y_[4], x_[4]; load_row_bf16(HN + (size_t)r_ * D, lane, y_); load_row_f32(xin__ + (size_t)r_ * D, lane, x_); \
            const float rs_ = rsqrtf(row_ssq(y_) * (1.f / D) + EPS); \
            _Pragma("unroll") for (int j_ = 0; j_ < 4; ++j_) { x_[j_] = x_[j_] + y_[j_] * rs_ * gp__[j_]; *(f32x4*)(X + (size_t)r_ * D + 4 * lane + 256 * j_) = x_[j_]; } \
            if (gpre__) { const float r2_ = rsqrtf(row_ssq(x_) * (1.f / D) + EPS); \
                _Pragma("unroll") for (int j_ = 0; j_ < 4; ++j_) x_[j_] = x_[j_] * r2_ * gq__[j_]; \
                store_row_bf16(HN + (size_t)r_ * D, lane, x_); \
                if (gws__) { float ga_[8]; \
                    _Pragma("unroll") for (int g_ = 0; g_ < 8; ++g_) { float a_ = 0.f; \
                        _Pragma("unroll") for (int j_ = 0; j_ < 4; ++j_) { const f32x4 w_ = *(const LAS f32x4*)(wgl + g_ * D + 4 * lane + 256 * j_); a_ += (x_[j_][0] * w_[0] + x_[j_][1] * w_[1]) + (x_[j_][2] * w_[2] + x_[j_][3] * w_[3]); } \
                        ga_[g_] = wave_sum(a_); } \
                    float out_ = 0.f; \
                    _Pragma("unroll") for (int g_ = 0; g_ < 8; ++g_) if (lane == g_) out_ = ga_[g_] + gb__[g_]; \
                    if (lane < 8) GATES[(size_t)r_ * 8 + lane] = out_; } } } \
        if (gws__) __syncthreads(); } while (0)

    for (int l = 0; l < DEPTH; ++l) {
        const int base = 2 + l * NPH_L, j = l >> 1;
        if ((l & 1) == 0) {
#define MLA_PTRS PH_PTRS const bf16* wm = W + WE_MLA + j * WE_MLA_SZ; bf16* PROJ = (bf16*)(BIG + B_QN); bf16* QN = (bf16*)(BIG + B_QN); bf16* QR = (bf16*)(BIG + B_QR); bf16* VT = (bf16*)(BIG + B_VT); \
            bf16* CQN = (bf16*)(BIG + B_CQN); bf16* CKVN = (bf16*)(BIG + B_CKVN); bf16* KR = (bf16*)(BIG + B_KR); bf16* KN = HN; \
            (void)wm; (void)PROJ; (void)QN; (void)QR; (void)VT; (void)CQN; (void)CKVN; (void)KR; (void)KN;
            if constexpr (SEL(2)) if (INP(base + 0)) { MLA_PTRS
                pg8::Gemm g{HN, wm + WE_MLA_IN, M, MLA_INP, D}; pg8::StaticOrder S; S.init(M, MLA_INP, G, bx); pg8::EpiPlain E{PROJ, (size_t)MLA_INP, 1.f};
                pg8::gemm_phase<pg8::EpiPlain, pg8::StaticOrder, true, true>(lds, g, S, E);
                SEAM(base + 0);
            }
            if constexpr (SEL(3)) if (INP(base + 1)) { PH_REGS MLA_PTRS
                const float* gq = INF(4) + j * QRANK; const float* gkv = INF(6) + j * KVRANK;
                for (int r = gw; r < M; r += NGW) { const bf16* p = PROJ + (size_t)r * MLA_INP;
                    float cq[6]; float s1 = 0.f;
#pragma unroll
                    for (int jj = 0; jj < 3; ++jj) { const unsigned w = *(const unsigned*)(p + 2 * lane + 128 * jj); cq[2 * jj] = bflo(w); cq[2 * jj + 1] = bfhi(w); s1 += cq[2 * jj] * cq[2 * jj] + cq[2 * jj + 1] * cq[2 * jj + 1]; }
                    const u32x2 wk = *(const u32x2*)(p + QRANK + 4 * lane); const f32x4 ck = (f32x4){bflo(wk.x), bfhi(wk.x), bflo(wk.y), bfhi(wk.y)};
                    float s2 = (ck[0] * ck[0] + ck[1] * ck[1]) + (ck[2] * ck[2] + ck[3] * ck[3]);
                    const float kr = bf2f(p[QRANK + KVRANK + lane]);
                    s1 = wave_sum(s1); s2 = wave_sum(s2);
                    const float r1 = rsqrtf(s1 * (1.f / QRANK) + EPS), r2 = rsqrtf(s2 * (1.f / KVRANK) + EPS);
#pragma unroll
                    for (int jj = 0; jj < 3; ++jj) { const int c0 = 2 * lane + 128 * jj; *(unsigned*)(CQN + (size_t)r * QRANK + c0) = pg8::cvt_pk_bf16(cq[2 * jj] * r1 * gq[c0], cq[2 * jj + 1] * r1 * gq[c0 + 1]); }
                    { const f32x4 g4 = *(const f32x4*)(gkv + 4 * lane); u32x2 w; w.x = pg8::cvt_pk_bf16(ck[0] * r2 * g4[0], ck[1] * r2 * g4[1]); w.y = pg8::cvt_pk_bf16(ck[2] * r2 * g4[2], ck[3] * r2 * g4[3]);
                      *(u32x2*)(CKVN + (size_t)r * KVRANK + 4 * lane) = w; }
                    { const float other = __shfl_xor(kr, 32); const int i = lane & 31; const float c = COS[(size_t)r * 32 + i], s = SIN[(size_t)r * 32 + i];
                      const float o = (lane < 32) ? (kr * c - other * s) : (kr * c + other * s);
                      KR[(size_t)r * 64 + lane] = (bf16)(pg8::cvt_pk_bf16(o, 0.f) & 0xffffu); }
                }
                SEAM(base + 1);
            }
            if constexpr (SEL(4)) if (INP(base + 2)) { MLA_PTRS
                { pg8::Gemm g{CQN, wm + WE_MLA_UQ, M, 1536, QRANK}; pg8::StaticOrder S; S.init(M, 1536, G, bx); pg8::EpiQ E{QN, QR, COS, SIN, MLA_QS};
                  pg8::gemm_phase<pg8::EpiQ, pg8::StaticOrder, true, true>(lds, g, S, E); }
                { pg8::Gemm g{CKVN, wm + WE_MLA_UKV, M, D, KVRANK}; pg8::StaticOrder S; S.init(M, D, G, bx); pg8::EpiPlain E{KN, (size_t)D, 1.f};
                  pg8::gemm_phase<pg8::EpiPlain, pg8::StaticOrder, true, true>(lds, g, S, E); }
                { pg8::Gemm g{wm + WE_MLA_UKV + (size_t)D * KVRANK, CKVN, D, M, KVRANK}; pg8::StaticOrder S; S.init(D, M, G, bx); pg8::EpiPlain E{VT, (size_t)M, 1.f};
                  pg8::gemm_phase<pg8::EpiPlain, pg8::StaticOrder, true, true>(lds, g, S, E); }
                SEAM(base + 2);
            }
            if constexpr (SEL(5)) if (INP(base + 3)) { PH_REGS MLA_PTRS
                LAS float* qs = (LAS float*)lds + wave * 2304; LAS float* sc = qs + 256;
                for (int r = gw; r < M * MLA_H; r += NGW) { const int bh = r / SEQ, b = bh >> 3, h = bh & 7, s = ((r % SEQ) + 977 * bh) % SEQ; const size_t row = (size_t)b * SEQ + s;
                    naive_attn_row<128, 64, 128>(QN + row * 1024 + h * 128, QR + row * 512 + h * 64, KN + (size_t)b * SEQ * 1024 + h * 128, 1024, KR + (size_t)b * SEQ * 64, 64, s + 1,
                                                 VT + (size_t)(h * 128) * M + (size_t)b * SEQ, (size_t)M, QN + row * 1024 + h * 128, qs, sc, lane); }
                SEAM(base + 3);
            }
            if constexpr (SEL(6)) if (INP(base + 4)) { MLA_PTRS
                pg8::Gemm g{QN, wm + WE_MLA_O, M, D, D}; pg8::StaticOrder S; S.init(M, D, G, bx); pg8::EpiPlain E{HN, (size_t)D, 1.f};
                pg8::gemm_phase<pg8::EpiPlain, pg8::StaticOrder, true, true>(lds, g, S, E);
                SEAM(base + 4);
            }
        } else {
#define L_PTRS PH_PTRS const bf16* wl = W + WE_L + j * WE_L_SZ; bf16* QK = (bf16*)(BIG + B_QK); bf16* OG = (bf16*)(BIG + B_OG); bf16* KVT = (bf16*)(BIG + B_KVT); bf16* HS = HN; bf16* GA = (bf16*)(BIG + B_QK); \
            (void)wl; (void)QK; (void)OG; (void)KVT; (void)HS; (void)GA;
            if constexpr (SEL(7)) if (INP(base + 0)) { L_PTRS
                { pg8::Gemm g{HN, wl + WE_L_IN, M, 2048, D}; pg8::StaticOrder S; S.init(M, 2048, G, bx); pg8::EpiQKO E{QK, OG, LQ_S};
                  pg8::gemm_phase<pg8::EpiQKO, pg8::StaticOrder, true, true>(lds, g, S, E); }
                { pg8::Gemm g{wl + WE_L_IN + (size_t)2048 * D, HN, 1536, M, D}; pg8::StaticOrder S; S.init(1536, M, G, bx); pg8::EpiPlain E{KVT, (size_t)M, 1.f};
                  pg8::gemm_phase<pg8::EpiPlain, pg8::StaticOrder, true, true>(lds, g, S, E); }
                SEAM(base + 0);
            }
            if constexpr (SEL(8)) if (INP(base + 1)) { PH_REGS L_PTRS
                for (int u = bx; u < NB * LH * 4; u += G) naive_scan_unit(u, QK, KVT, GATES, HS, lds, tid);
                SEAM(base + 1);
            }
            if constexpr (SEL(9)) if (INP(base + 2)) { PH_REGS L_PTRS
                const float* hn = INF(11) + j * LH * LDV;
                for (int r = gw; r < M; r += NGW) {
#pragma unroll
                    for (int hh = 0; hh < 4; ++hh) { const u32x2 wh = *(const u32x2*)(HS + (size_t)r * D + hh * 256 + 4 * lane); const u32x2 wo = *(const u32x2*)(OG + (size_t)r * D + hh * 256 + 4 * lane);
                        const f32x4 hv = (f32x4){bflo(wh.x), bfhi(wh.x), bflo(wh.y), bfhi(wh.y)}, ov = (f32x4){bflo(wo.x), bfhi(wo.x), bflo(wo.y), bfhi(wo.y)};
                        const float ss = wave_sum((hv[0] * hv[0] + hv[1] * hv[1]) + (hv[2] * hv[2] + hv[3] * hv[3])); const float rs = rsqrtf(ss * (1.f / LDV) + EPS);
                        const f32x4 g4 = *(const f32x4*)(hn + hh * 256 + 4 * lane); const f32x4 o = hv * rs * g4 * ov;
                        u32x2 w; w.x = pg8::cvt_pk_bf16(o[0], o[1]); w.y = pg8::cvt_pk_bf16(o[2], o[3]); *(u32x2*)(GA + (size_t)r * D + hh * 256 + 4 * lane) = w; } }
                SEAM(base + 2);
            }
            if constexpr (SEL(10)) if (INP(base + 4)) { L_PTRS
                pg8::Gemm g{GA, wl + WE_L_O, M, D, D}; pg8::StaticOrder S; S.init(M, D, G, bx); pg8::EpiPlain E{HN, (size_t)D, 1.f};
                pg8::gemm_phase<pg8::EpiPlain, pg8::StaticOrder, true, true>(lds, g, S, E);
                SEAM(base + 4);
            }
        }
        if constexpr (SEL(11)) if (INP(base + 5)) { PH_REGS PH_PTRS ROW_PASS((l == 0) ? INF(0) : (const float*)X, INF(14) + l * D, INF(15) + l * D, (const float*)nullptr, (const float*)nullptr); SEAM(base + 5); }
        {
#define MEM_PTRS PH_PTRS const bf16* wmm = W + WE_M + l * WE_M_SZ; bf16* QM = (bf16*)(BIG + B_QM); (void)wmm; (void)QM;
            if constexpr (SEL(12)) if (INP(base + 6)) { MEM_PTRS
                pg8::Gemm g{HN, wmm + WE_M_Q, M, D, D}; pg8::StaticOrder S; S.init(M, D, G, bx); pg8::EpiPlain E{QM, (size_t)D, MEM_QS};
                pg8::gemm_phase<pg8::EpiPlain, pg8::StaticOrder, true, true>(lds, g, S, E);
                SEAM(base + 6);
            }
            if constexpr (SEL(13)) if (INP(base + 7)) { PH_REGS MEM_PTRS
                LAS float* qs = (LAS float*)lds + wave * 2304; LAS float* sc = qs + 256;
                const bf16* km = KM + (size_t)l * MMEM * D; const bf16* vmt = VMT + (size_t)l * D * MMEM;
                for (int r = gw; r < M * 4; r += NGW) { const int row = r >> 2, h = r & 3, b = row / SEQ;
                    naive_attn_row<256, 0, 256>(QM + (size_t)row * D + h * 256, nullptr, km + (size_t)b * NMEM * D + h * 256, (size_t)D, nullptr, 0, NMEM,
                                                vmt + (size_t)(h * 256) * MMEM + b * NMEM, (size_t)MMEM, QM + (size_t)row * D + h * 256, qs, sc, lane); }
                SEAM(base + 7);
            }
            if constexpr (SEL(14)) if (INP(base + 8)) { MEM_PTRS
                pg8::Gemm g{QM, wmm + WE_M_O, M, D, D}; pg8::StaticOrder S; S.init(M, D, G, bx); pg8::EpiPlain E{HN, (size_t)D, 1.f};
                pg8::gemm_phase<pg8::EpiPlain, pg8::StaticOrder, true, true>(lds, g, S, E);
                SEAM(base + 8);
            }
            if constexpr (SEL(15)) if (INP(base + 9)) { PH_REGS PH_PTRS ROW_PASS((const float*)X, INF(17) + l * D, INF(18) + l * D, (const float*)nullptr, (const float*)nullptr); SEAM(base + 9); }
        }
        {
#define FFN_PTRS PH_PTRS const bf16* wf = W + WE_F + l * WE_F_SZ; bf16* HID = (bf16*)(BIG + B_HID); (void)wf; (void)HID;
            if constexpr (SEL(16)) if (INP(base + 10)) { FFN_PTRS
                pg8::Gemm g{HN, wf + WE_F_GU, M, 2 * DFF, D}; pg8::StaticOrder S; S.init(M, 2 * DFF, G, bx); pg8::EpiSwiGLU E{HID, (size_t)DFF};
                pg8::gemm_phase<pg8::EpiSwiGLU, pg8::StaticOrder, true, true>(lds, g, S, E);
                SEAM(base + 10);
            }
            if constexpr (SEL(17)) if (INP(base + 11)) { FFN_PTRS
                pg8::Gemm g{HID, wf + WE_F_D, M, D, DFF}; pg8::StaticOrder S; S.init(M, D, G, bx); pg8::EpiPlain E{HN, (size_t)D, 1.f};
                pg8::gemm_phase<pg8::EpiPlain, pg8::StaticOrder, true, true>(lds, g, S, E);
                SEAM(base + 11);
            }
            if constexpr (SEL(18)) if (INP(base + 12)) { PH_REGS PH_PTRS
                const bool nxt_l = (l + 1 < DEPTH) && ((l + 1) & 1);
                ROW_PASS((const float*)X, INF(19) + l * D, (l + 1 < DEPTH) ? INF(13) + (l + 1) * D : (const float*)nullptr,
                         nxt_l ? INF(9) + (size_t)j * D * MLSTM_IN : (const float*)nullptr, nxt_l ? INF(10) + j * 8 : (const float*)nullptr);
                SEAM(base + 12);
            }
        }
    }
}

template <int S> static void launch_site(const Args& a, hipStream_t stream) {
    static bool attr = false;
    if (!attr) { attr = true; if (hipFuncSetAttribute((const void*)fwd<S>, hipFuncAttributeMaxDynamicSharedMemorySize, LDS_BYTES) != hipSuccess) fprintf(stderr, "kernel_launch: hipFuncSetAttribute failed (site %d)\n", S); }
    hipLaunchKernelGGL(fwd<S>, dim3(256), dim3(NWAVES * 64), LDS_BYTES, stream, a);
}
extern "C" void kernel_launch(void* const* d_in, const int* in_sizes, int n_in, void* d_out, int out_size, void* d_ws, size_t ws_size, hipStream_t stream) {
    if (n_in != 25 || out_size != M * D || ws_size < WS_END) { fprintf(stderr, "kernel_launch: unexpected shapes (n_in %d out %d ws %zu)\n", n_in, out_size, ws_size); return; }
    (void)hipMemsetAsync((char*)d_ws + WS_CTL, 0, CTL_ZERO_BYTES, stream);
    Args a{};
    for (int i = 0; i < 25; ++i) a.in[i] = d_in[i];
    a.out = (float*)d_out; a.ws = (unsigned char*)d_ws;
#if MK_ONE_LAUNCH
    a.lo = 0; a.hi = NPHASES;
    launch_site<-1>(a, stream);
#else
    for (int p = 0; p < NPHASES; ++p) {
        a.lo = p; a.hi = p + 1;
        if (p == 0) { launch_site<0>(a, stream); continue; }
        if (p == 1) { launch_site<1>(a, stream); continue; }
        const int k = (p - 2) % NPH_L, l = (p - 2) / NPH_L; const bool mla = (l & 1) == 0;
        switch (k) {
        case 0: if (mla) launch_site<2>(a, stream); else launch_site<7>(a, stream); break;
        case 1: if (mla) launch_site<3>(a, stream); else launch_site<8>(a, stream); break;
        case 2: if (mla) launch_site<4>(a, stream); else launch_site<9>(a, stream); break;
        case 3: if (mla) launch_site<5>(a, stream); break;
        case 4: if (mla) launch_site<6>(a, stream); else launch_site<10>(a, stream); break;
        case 5: launch_site<11>(a, stream); break;
        case 6: launch_site<12>(a, stream); break;
        case 7: launch_site<13>(a, stream); break;
        case 8: launch_site<14>(a, stream); break;
        case 9: launch_site<15>(a, stream); break;
        case 10: launch_site<16>(a, stream); break;
        case 11: launch_site<17>(a, stream); break;
        default: launch_site<18>(a, stream); break;
        }
    }
#endif
}
```

```cpp
#include <hip/hip_runtime.h>
#include <cstdio>
#include <cstdint>
namespace pg8 {
#define PG8_LAS __attribute__((address_space(3)))
typedef unsigned short bf16_t;
typedef short bf16x8 __attribute__((ext_vector_type(8)));
typedef float f32x4 __attribute__((ext_vector_type(4)));
typedef unsigned u32x4 __attribute__((ext_vector_type(4)));
constexpr int BM = 256, BK = 64, HALF = 128, HTB = HALF * BK * 2  , STAGE_BYTES = 8 * HTB, NXCD = 8, WGM = 8;

__host__ __device__ __forceinline__ int lds_byte(int r, int c) { const int st = (r >> 4) * 2 + (c >> 5), rr = r & 15, cc = c & 31, ob = rr * 64 + cc * 2; return st * 1024 + (ob ^ (((ob >> 9) & 1) << 5)); }
__host__ __device__ __forceinline__ void stage_rc(int b, int& R, int& C) { const int st = b / 1024, sb = b % 1024, swz = sb ^ (((sb >> 9) & 1) << 5); R = (st >> 1) * 16 + swz / 64; C = (st & 1) * 32 + (swz % 64) / 2; }
__host__ __device__ __forceinline__ int perm32(int rho) { const int n = rho >> 4, i = rho & 15; return 8 * (i >> 2) + 4 * n + (i & 3); }

__device__ __forceinline__ int lane_id() { int l; asm volatile("v_mbcnt_lo_u32_b32 %0, -1, 0\n\tv_mbcnt_hi_u32_b32 %0, -1, %0" : "=v"(l)); return l; }
struct Unit { int pm, pn, w; };
struct Gemm { const bf16_t* A; const bf16_t* Bt; int M, N, K; };

struct StaticOrder {
    int nM, nN, nwg, G, c;
    __host__ __device__ __forceinline__ void init(int M, int N, int G_, int c_) { nM = M / BM; nN = N / BM; nwg = nM * nN; G = G_; c = c_; }
    __host__ __device__ __forceinline__ bool next(int i, Unit& u) const {
        const long L = (long)i * G + c; if (L >= nwg) return false;
        int wgid = (int)L; { const int q = nwg / NXCD, r = nwg % NXCD, xcd = wgid % NXCD, off = wgid / NXCD; wgid = (xcd < r ? xcd * (q + 1) : r * (q + 1) + (xcd - r) * q) + off; }
        const int nig = WGM * nN, gid = wgid / nig, fm = gid * WGM, gsz = (nM - fm) < WGM ? (nM - fm) : WGM;
        u.pm = fm + ((wgid % nig) % gsz); u.pn = (wgid % nig) / gsz; u.w = 0; return true;
    }
    __device__ __forceinline__ void a_ready(const Unit&) const {}
    __device__ __forceinline__ void done(const Unit&) const {}
    __device__ __forceinline__ const char* a_panel(const Unit& u, const Gemm& g, size_t tstep) const { return (const char*)g.A + (size_t)u.pm * tstep; }
    __device__ __forceinline__ const char* b_panel(const Unit& u, const Gemm& g, size_t tstep) const { return (const char*)g.Bt + (size_t)u.pn * tstep; }
};
struct OneOrder {
    Unit u0;
    __device__ __forceinline__ bool next(int i, Unit& u) const { u.pm = u0.pm; u.pn = u0.pn; u.w = 0; return i == 0; }
    __device__ __forceinline__ void a_ready(const Unit&) const {}
    __device__ __forceinline__ void done(const Unit&) const {}
    __device__ __forceinline__ const char* a_panel(const Unit& u, const Gemm& g, size_t tstep) const { return (const char*)g.A + (size_t)u.pm * tstep; }
    __device__ __forceinline__ const char* b_panel(const Unit& u, const Gemm& g, size_t tstep) const { return (const char*)g.Bt + (size_t)u.pn * tstep; }
};
struct DualOrder {
    StaticOrder s0, s1; const bf16_t* A1; const bf16_t* B1;
    __device__ __forceinline__ bool next(int i, Unit& u) const {
        const int r0 = s0.nwg / s0.G;
        if (i < r0) { const bool ok = s0.next(i, u); u.w = 0; return ok; }
        const bool ok = s1.next(i - r0, u); u.w = 1; return ok; }
    __device__ __forceinline__ void a_ready(const Unit&) const {}
    __device__ __forceinline__ void done(const Unit&) const {}
    __device__ __forceinline__ const char* a_panel(const Unit& u, const Gemm& g, size_t tstep) const { return (const char*)(u.w ? A1 : g.A) + (size_t)u.pm * tstep; }
    __device__ __forceinline__ const char* b_panel(const Unit& u, const Gemm& g, size_t tstep) const { return (const char*)(u.w ? B1 : g.Bt) + (size_t)u.pn * tstep; }
};
struct TriOrder {
    StaticOrder s0; long dA1, dB1, dA2, dB2;
    __device__ __forceinline__ bool next(int i, Unit& u) const {
        const int L = i * s0.G + s0.c; const bool in0 = L < s0.nwg;
        Unit a = {0, 0, 0}; if (in0) s0.next(i, a);
        const int idx = L - s0.nwg, x = idx & 7, j = idx >> 3, b = 2 * x + ((j >> 3) & 1), q = j & 3; const bool one = ((j >> 2) & 1) == 0;
        const int pm1 = one ? b : q, pn1 = one ? q : b;
        u.pm = in0 ? a.pm : pm1; u.pn = in0 ? a.pn : pn1; u.w = in0 ? 0 : (one ? 1 : 2);
        return in0 || idx < 128; }
    __device__ __forceinline__ void a_ready(const Unit&) const {}
    __device__ __forceinline__ void done(const Unit&) const {}
    __device__ __forceinline__ const char* a_panel(const Unit& u, const Gemm& g, size_t tstep) const { return (const char*)g.A + (u.w == 1 ? dA1 : 0l) + (u.w == 2 ? dA2 : 0l) + (size_t)u.pm * tstep; }
    __device__ __forceinline__ const char* b_panel(const Unit& u, const Gemm& g, size_t tstep) const { return (const char*)g.Bt + (u.w == 1 ? dB1 : 0l) + (u.w == 2 ? dB2 : 0l) + (size_t)u.pn * tstep; }
};
template <class E0, class E1> struct EpiDual {
    static constexpr bool PERM = true, AFTER_DRAIN = false; static constexpr int NST = E0::NST < E1::NST ? E0::NST : E1::NST; static_assert(E0::PERM && E1::PERM && !E0::AFTER_DRAIN && !E1::AFTER_DRAIN, "EpiDual: both epilogues PERM, in-stream");
    E0 e0; E1 e1;
    __device__ __forceinline__ void operator()(const f32x4 (&acc)[2][2][4][2], const Unit& u, int wr, int wc, int fr, int fq) const { if (u.w) e1(acc, u, wr, wc, fr, fq); else e0(acc, u, wr, wc, fr, fq); }
};

typedef float cvt_f32x2 __attribute__((ext_vector_type(2))); typedef __bf16 cvt_bf16x2 __attribute__((ext_vector_type(2)));
__device__ __forceinline__ unsigned cvt_pk_bf16(float lo, float hi) { const cvt_f32x2 v = {lo, hi}; const cvt_bf16x2 b = __builtin_convertvector(v, cvt_bf16x2); return __builtin_bit_cast(unsigned, b); }
typedef float f32x2 __attribute__((ext_vector_type(2)));
__device__ __forceinline__ u32x4 pack8(f32x4 a, f32x4 b) { u32x4 w; w.x = cvt_pk_bf16(a[0], a[1]); w.y = cvt_pk_bf16(a[2], a[3]); w.z = cvt_pk_bf16(b[0], b[1]); w.w = cvt_pk_bf16(b[2], b[3]); return w; }
__device__ __forceinline__ float rsq4(const float* rs, int row) { return rsqrtf(((rs[row] + rs[32768 + row]) + (rs[65536 + row] + rs[98304 + row])) * (1.f / 1024) + 1e-6f); }
template <int RSM> struct EpiPlainT {
    static constexpr bool PERM = true, AFTER_DRAIN = false; static constexpr int NST = 16;
    bf16_t* O; size_t ldc; float scale; const float* rs;
    __device__ __forceinline__ void operator()(const f32x4 (&acc)[2][2][4][2], const Unit& u, int wr, int wc, int, int) const {
        int ln_ = lane_id(); asm volatile("" : "+v"(ln_)); const int fr = ln_ & 15, fq = ln_ >> 4;
        const int row0 = u.pm * BM + wr * 64 + fr, col0 = u.pn * BM + wc * 32 + 8 * fq;
        f32x4 cs[2][2]; float srv[2][4];
        if (RSM == 1) {
#pragma unroll
            for (int ai = 0; ai < 2; ++ai)
#pragma unroll
                for (int m = 0; m < 4; ++m) srv[ai][m] = rsq4(rs, row0 + ai * HALF + m * 16) * scale; }
        if (RSM == 2) {
#pragma unroll
            for (int bj = 0; bj < 2; ++bj) { f32x4 a_ = (*(const f32x4*)(rs + col0 + bj * HALF) + *(const f32x4*)(rs + 32768 + col0 + bj * HALF)) + (*(const f32x4*)(rs + 65536 + col0 + bj * HALF) + *(const f32x4*)(rs + 98304 + col0 + bj * HALF));
                f32x4 b_ = (*(const f32x4*)(rs + col0 + bj * HALF + 4) + *(const f32x4*)(rs + 32768 + col0 + bj * HALF + 4)) + (*(const f32x4*)(rs + 65536 + col0 + bj * HALF + 4) + *(const f32x4*)(rs + 98304 + col0 + bj * HALF + 4));
#pragma unroll
                for (int j = 0; j < 4; ++j) { a_[j] = rsqrtf(a_[j] * (1.f / 1024) + 1e-6f) * scale; b_[j] = rsqrtf(b_[j] * (1.f / 1024) + 1e-6f) * scale; }
                cs[bj][0] = a_; cs[bj][1] = b_; } }
#pragma unroll
        for (int ai = 0; ai < 2; ++ai)
#pragma unroll
            for (int m = 0; m < 4; ++m) { const int row = row0 + ai * HALF + m * 16; bf16_t* rowp = O + (size_t)row * ldc + col0;
                const float sr = (RSM == 1) ? srv[ai][m] : scale;
#pragma unroll
                for (int bj = 0; bj < 2; ++bj) {
                    if (RSM == 2) *(u32x4*)(rowp + bj * HALF) = pack8(acc[ai][bj][m][0] * cs[bj][0], acc[ai][bj][m][1] * cs[bj][1]);
                    else if (RSM == 0) *(u32x4*)(rowp + bj * HALF) = pack8(acc[ai][bj][m][0], acc[ai][bj][m][1]);
                    else *(u32x4*)(rowp + bj * HALF) = pack8(acc[ai][bj][m][0] * sr, acc[ai][bj][m][1] * sr); } }
    }
};
typedef EpiPlainT<0> EpiPlain;
struct EpiTri {
    static constexpr bool PERM = true, AFTER_DRAIN = false; static constexpr int NST = 16;
    bf16_t* O0; size_t ld0; const float* rs; long dO1, dl1, dO2, dl2;
    __device__ __forceinline__ void operator()(const f32x4 (&acc)[2][2][4][2], const Unit& u, int wr, int wc, int, int) const {
        int ln_ = lane_id(); asm volatile("" : "+v"(ln_)); const int fr = ln_ & 15, fq = ln_ >> 4;
        bf16_t* O = O0 + (u.w == 1 ? dO1 : 0l) + (u.w == 2 ? dO2 : 0l); const size_t ldc = ld0 + (u.w == 1 ? dl1 : 0l) + (u.w == 2 ? dl2 : 0l);
        const int row0 = u.pm * BM + wr * 64 + fr, col0 = u.pn * BM + wc * 32 + 8 * fq;
        float srv[2][4];
#pragma unroll
        for (int ai = 0; ai < 2; ++ai)
#pragma unroll
            for (int m = 0; m < 4; ++m) { srv[ai][m] = 1.f; if (u.w == 0) srv[ai][m] = rsq4(rs, row0 + ai * HALF + m * 16); }
#pragma unroll
        for (int ai = 0; ai < 2; ++ai)
#pragma unroll
            for (int m = 0; m < 4; ++m) { const int row = row0 + ai * HALF + m * 16; bf16_t* rowp = O + (size_t)row * ldc + col0;
                const float sr = srv[ai][m];
#pragma unroll
                for (int bj = 0; bj < 2; ++bj) *(u32x4*)(rowp + bj * HALF) = pack8(acc[ai][bj][m][0] * sr, acc[ai][bj][m][1] * sr); }
    }
};
struct EpiLN {
    static constexpr bool PERM = true, AFTER_DRAIN = false; static constexpr int NST = 16;
    bf16_t* XB; const float* gpost; float* rsq; float* EX; unsigned* tk; PG8_LAS float* red; unsigned colo; float* outf;
    __device__ __forceinline__ void operator()(const f32x4 (&acc)[2][2][4][2], const Unit& u, int wr, int wc, int, int) const {
        int ln_ = lane_id(); asm volatile("" : "+v"(ln_)); const int fr = ln_ & 15, fq = ln_ >> 4;
        const int t = (wr * 4 + wc) * 64 + ln_, rl0 = wr * 64 + fr, col0 = u.pn * BM + wc * 32 + 8 * fq;
        bf16_t* xrow0 = XB + (size_t)(u.pm * BM + rl0) * 1024 + col0;
        u32x4 xw[2][4][2];
#pragma unroll
        for (int ai = 0; ai < 2; ++ai)
#pragma unroll
            for (int m = 0; m < 4; ++m)
#pragma unroll
                for (int bj = 0; bj < 2; ++bj) xw[ai][m][bj] = *(const u32x4*)(xrow0 + (size_t)(ai * HALF + m * 16) * 1024 + bj * HALF);
#pragma unroll
        for (int ai = 0; ai < 2; ++ai)
#pragma unroll
            for (int m = 0; m < 4; ++m) { float p = 0.f;
#pragma unroll
                for (int bj = 0; bj < 2; ++bj)
#pragma unroll
                    for (int n = 0; n < 2; ++n) { const f32x4 v = acc[ai][bj][m][n]; p += (v[0] * v[0] + v[1] * v[1]) + (v[2] * v[2] + v[3] * v[3]); }
                p += __builtin_bit_cast(float, __builtin_amdgcn_ds_bpermute(((ln_ ^ 16) << 2), __builtin_bit_cast(int, p))); p += __builtin_bit_cast(float, __builtin_amdgcn_ds_bpermute(((ln_ ^ 32) << 2), __builtin_bit_cast(int, p)));
                if (fq == 0) red[wc * 256 + rl0 + ai * HALF + m * 16] = p; }
        asm volatile("s_waitcnt lgkmcnt(0)\n\ts_barrier" ::: "memory");
        float* exp_ = EX + (size_t)(u.pm * 4) * 256;
        if (t < 256) exp_[u.pn * 256 + t] = (red[t] + red[256 + t]) + (red[512 + t] + red[768 + t]);
        asm volatile("s_waitcnt vmcnt(0) lgkmcnt(0)\n\ts_barrier" ::: "memory");
        if (t == 0) { if (!colo) { __builtin_amdgcn_fence(__ATOMIC_RELEASE, "agent"); asm volatile("s_waitcnt vmcnt(0)" ::: "memory"); }
            unsigned* c_ = tk + u.pm * 16; (void)__hip_atomic_fetch_add(c_, 1u, __ATOMIC_RELAXED, __HIP_MEMORY_SCOPE_AGENT);
            unsigned sp_ = 0; while (__hip_atomic_load(c_, __ATOMIC_RELAXED, __HIP_MEMORY_SCOPE_AGENT) < 4u && ++sp_ < (1u << 22)) __builtin_amdgcn_s_sleep(1);
            if (!colo) { __builtin_amdgcn_fence(__ATOMIC_ACQUIRE, "agent"); asm volatile("s_waitcnt vmcnt(0)" ::: "memory"); } }
        asm volatile("s_waitcnt vmcnt(0) lgkmcnt(0)\n\ts_barrier" ::: "memory");
        if (t < 256) { float e_[4];
#pragma unroll
            for (int q = 0; q < 4; ++q) e_[q] = __builtin_bit_cast(float, __hip_atomic_load((const unsigned*)(exp_ + q * 256 + t), __ATOMIC_RELAXED, __HIP_MEMORY_SCOPE_AGENT));
            red[1024 + t] = rsqrtf(((e_[0] + e_[1]) + (e_[2] + e_[3])) * (1.f / 1024) + 1e-6f); }
        f32x4 gp[2][2];
#pragma unroll
        for (int bj = 0; bj < 2; ++bj)
#pragma unroll
            for (int n = 0; n < 2; ++n) gp[bj][n] = *(const f32x4*)(gpost + col0 + bj * HALF + 4 * n);
        asm volatile("s_waitcnt vmcnt(0) lgkmcnt(0)\n\ts_barrier" ::: "memory");
        unsigned zo_ = 0; asm volatile("" : "+v"(zo_)); bf16_t* xst = xrow0 + zo_;
#pragma unroll
        for (int ai = 0; ai < 2; ++ai)
#pragma unroll
            for (int m = 0; m < 4; ++m) { const float inv = red[1024 + rl0 + ai * HALF + m * 16]; float p = 0.f;
#pragma unroll
                for (int bj = 0; bj < 2; ++bj) { const u32x4 w = xw[ai][m][bj];
                    f32x4 x0 = (f32x4){__builtin_bit_cast(float, w.x << 16), __builtin_bit_cast(float, w.x & 0xffff0000u), __builtin_bit_cast(float, w.y << 16), __builtin_bit_cast(float, w.y & 0xffff0000u)};
                    f32x4 x1 = (f32x4){__builtin_bit_cast(float, w.z << 16), __builtin_bit_cast(float, w.z & 0xffff0000u), __builtin_bit_cast(float, w.w << 16), __builtin_bit_cast(float, w.w & 0xffff0000u)};
                    x0 = x0 + acc[ai][bj][m][0] * inv * gp[bj][0]; x1 = x1 + acc[ai][bj][m][1] * inv * gp[bj][1];
                    p += ((x0[0] * x0[0] + x0[1] * x0[1]) + (x0[2] * x0[2] + x0[3] * x0[3])) + ((x1[0] * x1[0] + x1[1] * x1[1]) + (x1[2] * x1[2] + x1[3] * x1[3]));
                    if (outf) { float* op_ = outf + (size_t)(u.pm * BM + rl0 + ai * HALF + m * 16) * 1024 + col0 + bj * HALF + zo_; *(f32x4*)op_ = x0; *(f32x4*)(op_ + 4) = x1; }
                    else *(u32x4*)(xst + (size_t)(ai * HALF + m * 16) * 1024 + bj * HALF) = pack8(x0, x1); }
                p += __builtin_bit_cast(float, __builtin_amdgcn_ds_bpermute(((ln_ ^ 16) << 2), __builtin_bit_cast(int, p))); p += __builtin_bit_cast(float, __builtin_amdgcn_ds_bpermute(((ln_ ^ 32) << 2), __builtin_bit_cast(int, p)));
                if (fq == 0) red[wc * 256 + rl0 + ai * HALF + m * 16] = p; }
        asm volatile("s_waitcnt lgkmcnt(0)\n\ts_barrier" ::: "memory");
        if (t < 256 && !outf) rsq[(size_t)u.pn * 32768 + u.pm * BM + t] = (red[t] + red[256 + t]) + (red[512 + t] + red[768 + t]);
        asm volatile("s_waitcnt lgkmcnt(0)\n\ts_barrier" ::: "memory");
    }
};
struct EpiSplit {
    static constexpr bool PERM = true, AFTER_DRAIN = false; static constexpr int NST = 16;
    bf16_t* O0; size_t ld0; int nt0; bf16_t* O1; size_t ld1; float scale;
    __device__ __forceinline__ void operator()(const f32x4 (&acc)[2][2][4][2], const Unit& u, int wr, int wc, int, int) const {
        int ln_ = lane_id(); asm volatile("" : "+v"(ln_)); const int fr = ln_ & 15, fq = ln_ >> 4;
        const bool second = u.pn >= nt0; bf16_t* base = second ? O1 : O0; const size_t ldc = second ? ld1 : ld0;
        const int row0 = u.pm * BM + wr * 64 + fr, col0 = (second ? u.pn - nt0 : u.pn) * BM + wc * 32 + 8 * fq;
#pragma unroll
        for (int ai = 0; ai < 2; ++ai)
#pragma unroll
            for (int m = 0; m < 4; ++m) { bf16_t* rowp = base + (size_t)(row0 + ai * HALF + m * 16) * ldc + col0;
#pragma unroll
                for (int bj = 0; bj < 2; ++bj) *(u32x4*)(rowp + bj * HALF) = pack8(acc[ai][bj][m][0] * scale, acc[ai][bj][m][1] * scale); }
    }
};
struct EpiSwiGLU {
    static constexpr bool PERM = true, AFTER_DRAIN = false; static constexpr int NST = 8;
    bf16_t* O; size_t ldc; const float* rs;
    __device__ __forceinline__ void operator()(const f32x4 (&acc)[2][2][4][2], const Unit& u, int wr, int wc, int, int) const {
        int ln_ = lane_id(); asm volatile("" : "+v"(ln_)); const int fr = ln_ & 15, fq = ln_ >> 4;
        const int row0 = u.pm * BM + wr * 64 + fr, col0 = u.pn * HALF + wc * 32 + 8 * fq;
        float srv[2][4];
#pragma unroll
        for (int ai = 0; ai < 2; ++ai)
#pragma unroll
            for (int m = 0; m < 4; ++m) srv[ai][m] = rsq4(rs, row0 + ai * HALF + m * 16);
#pragma unroll
        for (int ai = 0; ai < 2; ++ai)
#pragma unroll
            for (int m = 0; m < 4; ++m) { f32x4 h[2]; const float sr = srv[ai][m];
#pragma unroll
                for (int n = 0; n < 2; ++n) { const f32x4 g = acc[ai][0][m][n] * sr, up = acc[ai][1][m][n] * sr;
#pragma unroll
                    for (int j = 0; j < 4; ++j) h[n][j] = g[j] * up[j] * __builtin_amdgcn_rcpf(1.f + __expf(-g[j])); }
                *(u32x4*)(O + (size_t)(row0 + ai * HALF + m * 16) * ldc + col0) = pack8(h[0], h[1]); }
    }
};
struct EpiQKO {
    static constexpr bool PERM = true, AFTER_DRAIN = false; static constexpr int NST = 16;
    bf16_t* QK; bf16_t* OG; float qscale; const float* rs;
    __device__ __forceinline__ void operator()(const f32x4 (&acc)[2][2][4][2], const Unit& u, int wr, int wc, int, int) const {
        int ln_ = lane_id(); asm volatile("" : "+v"(ln_)); const int fr = ln_ & 15, fq = ln_ >> 4;
        const int row0 = u.pm * BM + wr * 64 + fr; const bool gate = u.pn >= 4;
        bf16_t* base = gate ? OG : QK; const int col0 = (gate ? u.pn - 4 : u.pn) * BM + wc * 32 + 8 * fq; const float sc = u.pn < 2 ? qscale : 1.f;
        float srv[2][4];
#pragma unroll
        for (int ai = 0; ai < 2; ++ai)
#pragma unroll
            for (int m = 0; m < 4; ++m) srv[ai][m] = sc * rsq4(rs, row0 + ai * HALF + m * 16);
#pragma unroll
        for (int ai = 0; ai < 2; ++ai)
#pragma unroll
            for (int m = 0; m < 4; ++m) { bf16_t* rowp = base + (size_t)(row0 + ai * HALF + m * 16) * 1024 + col0;
#pragma unroll
                for (int bj = 0; bj < 2; ++bj) { const float sr = srv[ai][m]; f32x4 v0 = acc[ai][bj][m][0] * sr, v1 = acc[ai][bj][m][1] * sr;
                    if (gate) {
#pragma unroll
                        for (int j = 0; j < 4; ++j) { v0[j] = __builtin_amdgcn_rcpf(1.f + __expf(-v0[j])); v1[j] = __builtin_amdgcn_rcpf(1.f + __expf(-v1[j])); } }
                    *(u32x4*)(rowp + bj * HALF) = pack8(v0, v1); } }
    }
};

template <class Epi, class Sched, bool ALIGN_EPI = false, bool SP2 = false>
__device__ __forceinline__ void gemm_phase(PG8_LAS unsigned char* lds, const Gemm g, const Sched& S, const Epi& E, const int wave_s) {
    int tid_l = wave_s * 64 + lane_id(); asm volatile("" : "+v"(tid_l));
    const int tid = tid_l, wid = __builtin_amdgcn_readfirstlane(tid >> 6), lane = tid & 63, wr = wid >> 2, wc = wid & 3, fr = lane & 15, fq = lane >> 4;
    const int K = g.K, nt = K / BK;
    unsigned voffA[2], voffB[2];
#pragma unroll
    for (int i = 0; i < 2; ++i) { int R, C; stage_rc(tid * 16 + i * 8192, R, C); const int Rb = Epi::PERM ? ((R & ~31) + perm32(R & 31)) : R;
        voffA[i] = (unsigned)(R * K + C) * 2u; voffB[i] = (unsigned)(Rb * K + C) * 2u; }
    const size_t kstep = (size_t)(BK * 2);
    const size_t hstep = (size_t)HALF * K * 2;
    const size_t tstep = 2 * hstep;
    const unsigned ldsw = (unsigned)wid * 1024u;
    const int aoff = lds_byte(wr * 64 + fr, fq * 8), boff = lds_byte(wc * 32 + fr, fq * 8);
#define PG8_SA(b, h) (((b) * 2 + (h)) * HTB)
#define PG8_SB(b, h) ((4 + (b) * 2 + (h)) * HTB)
#define PG8_STAGE(bufoff, gbase, voff) do { _Pragma("unroll") for (int _i = 0; _i < 2; ++_i) \
        __builtin_amdgcn_global_load_lds((const unsigned*)((const char*)(gbase) + (voff)[_i]), (PG8_LAS unsigned*)(lds + (bufoff) + ldsw + _i * 8192), 16, 0, 0); } while (0)
#define PG8_LDA(dst, b, h) do { _Pragma("unroll") for (int m = 0; m < 4; ++m) _Pragma("unroll") for (int k = 0; k < 2; ++k) dst[m][k] = *(const PG8_LAS bf16x8*)(lds + PG8_SA(b, h) + aoff + m * 2048 + k * 1024); } while (0)
#define PG8_LDB(dst, b, h) do { _Pragma("unroll") for (int n = 0; n < 2; ++n) _Pragma("unroll") for (int k = 0; k < 2; ++k) dst[n][k] = *(const PG8_LAS bf16x8*)(lds + PG8_SB(b, h) + boff + n * 2048 + k * 1024); } while (0)
#define PG8_MMA(ai, bj, At, Bt) do { __builtin_amdgcn_s_setprio(1); _Pragma("unroll") for (int m = 0; m < 4; ++m) _Pragma("unroll") for (int n = 0; n < 2; ++n) _Pragma("unroll") for (int k = 0; k < 2; ++k) \
        acc[ai][bj][m][n] = __builtin_amdgcn_mfma_f32_16x16x32_bf16(Bt[n][k], At[m][k], acc[ai][bj][m][n], 0, 0, 0); __builtin_amdgcn_s_setprio(0); } while (0)
#define PG8_WAIT_V(n) asm volatile("s_waitcnt vmcnt(" #n ")" ::: "memory")
#define PG8_WAIT_VN(n) asm volatile("s_waitcnt vmcnt(%0)" :: "n"(n) : "memory")
    constexpr bool HOIST = ALIGN_EPI && SP2 && !Epi::AFTER_DRAIN;
#define PG8_WAIT_L(n) asm volatile("s_waitcnt lgkmcnt(" #n ")" ::: "memory")
#define PG8_BAR __builtin_amdgcn_s_barrier()
#define PG8_SCHED __builtin_amdgcn_sched_barrier(0)
    Unit cur, nxt; int ui = 0;
    if (!S.next(0, cur)) return;
    f32x4 acc[2][2][4][2];
#pragma unroll
    for (int a = 0; a < 2; ++a)
#pragma unroll
        for (int b = 0; b < 2; ++b)
#pragma unroll
            for (int m = 0; m < 4; ++m)
#pragma unroll
                for (int n = 0; n < 2; ++n) acc[a][b][m][n] = (f32x4){0.f, 0.f, 0.f, 0.f};
    bf16x8 At[4][2], B0[2][2], B1[2][2];
    const char* cA = S.a_panel(cur, g, tstep); const char* cB = S.b_panel(cur, g, tstep);
    S.a_ready(cur);
    if constexpr (SP2) {
        PG8_STAGE(PG8_SB(0, 0), cB, voffB); PG8_STAGE(PG8_SB(0, 1), cB + hstep, voffB); PG8_STAGE(PG8_SA(0, 0), cA, voffA); PG8_STAGE(PG8_SA(0, 1), cA + hstep, voffA);
        if (wr == 1) PG8_BAR;
        PG8_WAIT_V(2); PG8_BAR;
        PG8_STAGE(PG8_SB(1, 0), cB + kstep, voffB); PG8_STAGE(PG8_SA(1, 0), cA + kstep, voffA); PG8_STAGE(PG8_SB(1, 1), cB + hstep + kstep, voffB);
        PG8_WAIT_V(6); PG8_BAR;
    } else {
        PG8_STAGE(PG8_SB(0, 0), cB, voffB); PG8_STAGE(PG8_SA(0, 0), cA, voffA); PG8_STAGE(PG8_SB(0, 1), cB + hstep, voffB); PG8_STAGE(PG8_SA(0, 1), cA + hstep, voffA);
        if (wr == 1) PG8_BAR;
        PG8_WAIT_V(4); PG8_BAR;
        PG8_STAGE(PG8_SB(1, 0), cB + kstep, voffB); PG8_STAGE(PG8_SA(1, 0), cA + kstep, voffA); PG8_STAGE(PG8_SB(1, 1), cB + hstep + kstep, voffB);
        PG8_WAIT_V(6); PG8_BAR;
    }
    for (;;) {
        const bool has_next = S.next(ui + 1, nxt);
        const char* nA = has_next ? S.a_panel(nxt, g, tstep) : cA; const char* nB = has_next ? S.b_panel(nxt, g, tstep) : cB;
#pragma nounroll
        for (int t = 0; t < nt; t += 2) {
            const bool last = (t == nt - 2), first = HOIST && (t == 0) && (ui > 0);
            const char* a1 = cA + (size_t)(t + 1) * kstep;
            const char* a2 = last ? nA : cA + (size_t)(t + 2) * kstep; const char* b2 = last ? nB : cB + (size_t)(t + 2) * kstep;
            const char* a3 = a2 + kstep; const char* b3 = b2 + kstep;
            if (last && has_next) S.a_ready(nxt);
            if constexpr (SP2) {
            PG8_LDB(B0, 0, 0); PG8_LDB(B1, 0, 1); PG8_SCHED; PG8_LDA(At, 0, 0); if (!first) PG8_STAGE(PG8_SA(1, 1), a1 + hstep, voffA);
            if (first) PG8_WAIT_VN(8 + Epi::NST); else PG8_WAIT_V(8); PG8_WAIT_L(0); PG8_BAR; PG8_MMA(0, 0, At, B0); PG8_MMA(0, 1, At, B1); PG8_BAR; PG8_SCHED;
            PG8_LDA(At, 0, 1); PG8_STAGE(PG8_SB(0, 0), b2, voffB); PG8_STAGE(PG8_SB(0, 1), b2 + hstep, voffB); PG8_STAGE(PG8_SA(0, 0), a2, voffA);
            if (first) PG8_WAIT_VN(8 + Epi::NST); else PG8_WAIT_V(8); PG8_WAIT_L(0); PG8_BAR; PG8_MMA(1, 0, At, B0); PG8_MMA(1, 1, At, B1); PG8_BAR; PG8_SCHED;
            PG8_LDB(B0, 1, 0); PG8_LDB(B1, 1, 1); PG8_SCHED; PG8_LDA(At, 1, 0); PG8_STAGE(PG8_SA(0, 1), a2 + hstep, voffA);
            if (first) PG8_WAIT_VN(8 + Epi::NST); else PG8_WAIT_V(8); PG8_WAIT_L(0); PG8_BAR; PG8_MMA(0, 0, At, B0); PG8_MMA(0, 1, At, B1); PG8_BAR; PG8_SCHED;
            PG8_LDA(At, 1, 1); PG8_STAGE(PG8_SB(1, 0), b3, voffB); PG8_STAGE(PG8_SB(1, 1), b3 + hstep, voffB); PG8_STAGE(PG8_SA(1, 0), a3, voffA);
            PG8_WAIT_V(8); PG8_WAIT_L(0); PG8_BAR; PG8_MMA(1, 0, At, B0); PG8_MMA(1, 1, At, B1); PG8_BAR; PG8_SCHED;
            } else {
            PG8_LDB(B0, 0, 0); PG8_SCHED; PG8_LDA(At, 0, 0); PG8_STAGE(PG8_SA(1, 1), a1 + hstep, voffA);
            PG8_WAIT_L(8); PG8_BAR; PG8_WAIT_L(0); PG8_MMA(0, 0, At, B0); PG8_BAR; PG8_SCHED;
            PG8_LDB(B1, 0, 1); PG8_STAGE(PG8_SB(0, 0), b2, voffB);
            PG8_BAR; PG8_WAIT_L(0); PG8_MMA(0, 1, At, B1); PG8_BAR;
            PG8_LDA(At, 0, 1); PG8_STAGE(PG8_SA(0, 0), a2, voffA);
            PG8_BAR; PG8_WAIT_L(0); PG8_MMA(1, 0, At, B0); PG8_BAR; PG8_SCHED;
            PG8_STAGE(PG8_SB(0, 1), b2 + hstep, voffB);
            PG8_WAIT_V(6); PG8_BAR; PG8_MMA(1, 1, At, B1); PG8_BAR;
            PG8_LDB(B0, 1, 0); PG8_SCHED; PG8_LDA(At, 1, 0); PG8_STAGE(PG8_SA(0, 1), a2 + hstep, voffA);
            PG8_WAIT_L(8); PG8_BAR; PG8_WAIT_L(0); PG8_MMA(0, 0, At, B0); PG8_BAR; PG8_SCHED;
            PG8_LDB(B1, 1, 1); PG8_STAGE(PG8_SB(1, 0), b3, voffB);
            PG8_BAR; PG8_WAIT_L(0); PG8_MMA(0, 1, At, B1); PG8_BAR;
            PG8_LDA(At, 1, 1); PG8_STAGE(PG8_SA(1, 0), a3, voffA);
            PG8_BAR; PG8_WAIT_L(0); PG8_MMA(1, 0, At, B0); PG8_BAR; PG8_SCHED;
            PG8_STAGE(PG8_SB(1, 1), b3 + hstep, voffB);
            PG8_WAIT_V(6); PG8_BAR; PG8_MMA(1, 1, At, B1); PG8_BAR;
            }
        }
        if constexpr (ALIGN_EPI) { if (wr == 0) PG8_BAR; }
        if constexpr (HOIST) { if (has_next) PG8_STAGE(PG8_SA(1, 1), nA + kstep + hstep, voffA); }
        if constexpr (!Epi::AFTER_DRAIN) { E(acc, cur, wr, wc, fr, fq); S.done(cur); }
        if (!has_next) break;
#pragma unroll
        for (int a = 0; a < 2; ++a)
#pragma unroll
            for (int b = 0; b < 2; ++b)
#pragma unroll
                for (int m = 0; m < 4; ++m)
#pragma unroll
                    for (int n = 0; n < 2; ++n) acc[a][b][m][n] = (f32x4){0.f, 0.f, 0.f, 0.f};
        cur = nxt; cA = nA; cB = nB; ++ui;
        if constexpr (ALIGN_EPI) { if (wr == 1) PG8_BAR; }
    }
    PG8_WAIT_V(0);
    if constexpr (!ALIGN_EPI) { if (wr == 0) PG8_BAR; }
    PG8_BAR;
    if constexpr (Epi::AFTER_DRAIN) { E.fused(acc, cur, wr, wc, fr, fq, lds, wid, lane); S.done(cur); }
#undef PG8_SA
#undef PG8_SB
#undef PG8_STAGE
#undef PG8_LDA
#undef PG8_LDB
#undef PG8_MMA
#undef PG8_WAIT_V
#undef PG8_WAIT_VN
#undef PG8_WAIT_L
#undef PG8_BAR
#undef PG8_SCHED
}
}

constexpr int D = 1024, NB = 16, SEQ = 2048, M = NB * SEQ, DEPTH = 4;
constexpr int NMEM = 256, MMEM = NB * NMEM;
constexpr int DFF = 2816;
constexpr int MLA_H = 8, QRANK = 384, KVRANK = 256, MLA_IN = 704, MLA_INP = 768;
constexpr int LH = 4, LDK = 128, LDV = 256;
constexpr int MLSTM_IN = 3080;
constexpr float EPS = 1e-6f;
constexpr float LOG2E = 1.4426950408889634f;
constexpr float MLA_QS = 0.07216878364870322f * LOG2E;
constexpr float MEM_QS = 0.0625f * LOG2E;
constexpr float LQ_S = 0.08838834764831845f;
constexpr int NWAVES = 8;
constexpr int GTOK = M / 8;
constexpr int VT_LD = GTOK + 64, KVT_LD = GTOK + 64, VMT_LD = MMEM + 64;

constexpr size_t MiB = 1u << 20;
constexpr size_t WS_CTL = 0, CTL_ZERO_BYTES = 1 * MiB;
constexpr size_t WS_COS = 1 * MiB, WS_SIN = 5 * MiB;
constexpr size_t WS_GATES = 9 * MiB;
constexpr size_t WS_RS = 10 * MiB;
constexpr size_t WS_EX = 12 * MiB + MiB / 2;
constexpr size_t WS_W = 16 * MiB;
constexpr size_t WS_KM = 144 * MiB;
constexpr size_t WS_VMT = 176 * MiB;
constexpr size_t WS_HN = 212 * MiB;
constexpr size_t WS_BIG = 276 * MiB;
constexpr size_t WS_END = 512 * MiB;
constexpr size_t WE_MLA_IN = 0, WE_MLA_UQ = WE_MLA_IN + (size_t)MLA_INP * D, WE_MLA_UKV = WE_MLA_UQ + (size_t)1536 * QRANK, WE_MLA_O = WE_MLA_UKV + (size_t)2048 * KVRANK, WE_MLA_SZ = WE_MLA_O + (size_t)D * D;
constexpr size_t WE_L_IN = 0, WE_L_O = (size_t)3584 * D, WE_L_SZ = WE_L_O + (size_t)D * D;
constexpr size_t WE_M_Q = 0, WE_M_KV = (size_t)D * D, WE_M_O = WE_M_KV + (size_t)2048 * D, WE_M_SZ = WE_M_O + (size_t)D * D;
constexpr size_t WE_F_GU = 0, WE_F_D = (size_t)2 * DFF * D, WE_F_SZ = WE_F_D + (size_t)D * DFF;
constexpr size_t WE_MLA = 0, WE_L = WE_MLA + 2 * WE_MLA_SZ, WE_M = WE_L + 2 * WE_L_SZ, WE_F = WE_M + 4 * WE_M_SZ, WE_TOTAL = WE_F + 4 * WE_F_SZ;
static_assert(WS_W + WE_TOTAL * 2 <= WS_KM, "weights fit");
constexpr size_t S_GRP = 29 * MiB + MiB / 2;
static_assert(8 * S_GRP <= WS_END - WS_BIG, "slabs fit");
constexpr size_t B_QN = 0, B_QR = 8 * MiB, B_VT = 12 * MiB, B_CQN = 20 * MiB + MiB / 4, B_CKVN = 23 * MiB + MiB / 4, B_KR = 25 * MiB + MiB / 4;
constexpr size_t B_QM = 0;
constexpr size_t B_HID = 0;
constexpr size_t B_QK = 0, B_OG = 8 * MiB, B_KVT = 16 * MiB;
constexpr size_t B_MEMN0 = 27 * MiB, B_MEMN2 = 28 * MiB + MiB / 4;
static_assert(B_VT + (size_t)D * VT_LD * 2 <= B_CQN && B_KR + (size_t)GTOK * 64 * 2 <= B_MEMN0 && B_KVT + (size_t)1536 * KVT_LD * 2 <= B_MEMN2 && B_HID + (size_t)GTOK * DFF * 2 <= B_MEMN0 && B_MEMN2 + MiB <= S_GRP, "slab map");
static_assert(WS_VMT + (size_t)4 * D * VMT_LD * 2 <= WS_HN, "VMT fits");
__host__ __device__ __forceinline__ constexpr size_t memn_slab_off(int l) { return l == 0 ? B_MEMN0 : (l == 2 ? B_MEMN2 : (l == 1 ? 0 * MiB : 1 * MiB)); }

constexpr int RING_BYTES = 143360;
constexpr int LDSCTL_OFF = RING_BYTES, MISC_OFF = LDSCTL_OFF + 320;
constexpr int LDS_BYTES = 155648;

#define GAS __attribute__((address_space(1)))
#define LAS __attribute__((address_space(3)))
typedef unsigned short bf16;
typedef unsigned v4u __attribute__((ext_vector_type(4)));
typedef float f32x4 __attribute__((ext_vector_type(4)));
typedef short bf16x8 __attribute__((ext_vector_type(8)));
typedef GAS unsigned gu32;
typedef GAS unsigned long long gu64;
#define RLX_AGENT __ATOMIC_RELAXED, __HIP_MEMORY_SCOPE_AGENT
#define LDS_WAIT() asm volatile("s_waitcnt lgkmcnt(0)" ::: "memory")
#define VM_WAIT() asm volatile("s_waitcnt vmcnt(0)" ::: "memory")
__device__ __forceinline__ unsigned long long rt() { return __builtin_amdgcn_s_memrealtime(); }
__device__ __forceinline__ unsigned f2bf(float f) { unsigned u = __builtin_bit_cast(unsigned, f); return (u + 0x7fffu + ((u >> 16) & 1u)) >> 16; }
__device__ __forceinline__ unsigned pk2(float lo, float hi) { return f2bf(lo) | (f2bf(hi) << 16); }

#define XB_TMO      128
#define XB_XCNT(j)  (256  + 64 * (j))
#define XB_XSUB(j)  (1280 + 64 * (j))
#define XB_XGEN(j)  (2304 + 64 * (j))
#define XB_TOP      3328
#define XB_TOPGEN   3392
#define XB_XG64(j)  (3456 + 64 * (j))
#define XCD_BAR_WORDS 4480
#define XB_SPIN_CAP (1u << 18)

__device__ __forceinline__ unsigned xb_ld(unsigned* p)              { return __hip_atomic_load(p, __ATOMIC_RELAXED, __HIP_MEMORY_SCOPE_AGENT); }
__device__ __forceinline__ unsigned xb_add(unsigned* p, unsigned v) { return __hip_atomic_fetch_add(p, v, __ATOMIC_RELAXED, __HIP_MEMORY_SCOPE_AGENT); }
__device__ __forceinline__ unsigned xb_xcc_id() { return (unsigned)__builtin_amdgcn_s_getreg((3 << 11) | 20) & 0xFu; }
#define XB_SPIN(cond, bar) do { unsigned _sp = 0; while (cond) { __builtin_amdgcn_s_sleep(1); \
    if ((++_sp & 255u) == 0u) { if (xb_ld(&(bar)[XB_TMO])) break; if (_sp > XB_SPIN_CAP) { atomicAdd(&(bar)[XB_TMO], 1u); break; } } } } while (0)

struct XcdBarrier {
    unsigned* bar; unsigned x;
    volatile LAS unsigned* st;
};

__device__ __forceinline__ XcdBarrier xcd_barrier_post(unsigned* bar, volatile LAS unsigned* st, const int wave_s) {
    XcdBarrier b; b.bar = bar; b.x = xb_xcc_id(); b.st = st;
    if (wave_s == 0 && pg8::lane_id() == 0) { (void)xb_add(&bar[XB_XCNT(b.x)], 1u);
        (void)__hip_atomic_fetch_add((unsigned long long*)&bar[XB_XG64(b.x)], 1ull | (1ull << (16 + 6 * (blockIdx.x & 7u))), __ATOMIC_RELAXED, __HIP_MEMORY_SCOPE_AGENT); }
    return b;
}
__device__ __forceinline__ void xcd_barrier_complete(unsigned* bar, unsigned x, unsigned& nloc, unsigned& nx) {
    const unsigned G = gridDim.x * gridDim.y * gridDim.z;
    unsigned sum, cnt, mine, sp = 0u;
    for (;;) {
        sum = 0u; cnt = 0u; mine = 0u;
#pragma unroll
        for (unsigned j = 0; j < 16; ++j) { const unsigned c = xb_ld(&bar[XB_XCNT(j)]); sum += c; cnt += (c > 0u) ? 1u : 0u; mine = (j == x) ? c : mine; }
        if (sum == G) break;
        __builtin_amdgcn_s_sleep(1);
        if ((++sp & 255u) == 0u) { if (xb_ld(&bar[XB_TMO])) break; if (sp > XB_SPIN_CAP) { atomicAdd(&bar[XB_TMO], 1u); break; } }
    }
    nloc = mine > 0u ? mine : 1u; nx = cnt > 0u ? cnt : 1u;
}

__device__ __forceinline__ unsigned xcd_groups_colocated(unsigned* bar) {
    const unsigned G = gridDim.x * gridDim.y * gridDim.z; if (G != 256u) return 0u;
    unsigned long long w[16]; unsigned sp = 0u;
    for (;;) { unsigned sum = 0u;
#pragma unroll
        for (unsigned j = 0; j < 16; ++j) { w[j] = __hip_atomic_load((unsigned long long*)&bar[XB_XG64(j)], __ATOMIC_RELAXED, __HIP_MEMORY_SCOPE_AGENT); sum += (unsigned)(w[j] & 0xffffull); }
        if (sum == G) break;
        __builtin_amdgcn_s_sleep(1);
        if ((++sp & 255u) == 0u) { if (xb_ld(&bar[XB_TMO])) return 0u; if (sp > XB_SPIN_CAP) { atomicAdd(&bar[XB_TMO], 1u); return 0u; } } }
    unsigned ok = 1u;
#pragma unroll
    for (unsigned j = 0; j < 16; ++j) { const unsigned cnt = (unsigned)(w[j] & 0xffffull); if (cnt == 0u) continue; unsigned one = 0u;
#pragma unroll
        for (unsigned g = 0; g < 8; ++g) one += (((unsigned)(w[j] >> (16 + 6 * g)) & 63u) == 32u) ? 1u : 0u;
        if (cnt != 32u || one != 1u) ok = 0u; }
    return ok;
}

__device__ __forceinline__ void xcd_barrier(const XcdBarrier& b, const int wave_s) {
    asm volatile("s_waitcnt vmcnt(0)" ::: "memory");
    __syncthreads();
    if (wave_s == 0 && pg8::lane_id() == 0) {
        unsigned* bar = b.bar;
        __builtin_amdgcn_s_waitcnt(0);
        unsigned nloc = b.st[0], nx = b.st[1];
        if (nloc == 0u) { xcd_barrier_complete(bar, b.x, nloc, nx); b.st[0] = nloc; b.st[1] = nx; b.st[2] = xcd_groups_colocated(bar); }
        const unsigned old = xb_add(&bar[XB_XSUB(b.x)], 1u);
        const unsigned gen = old / nloc;
        if (old + 1u == (gen + 1u) * nloc) {
            __builtin_amdgcn_fence(__ATOMIC_RELEASE, "agent");
            asm volatile("s_waitcnt vmcnt(0)" ::: "memory");
            const unsigned og = xb_add(&bar[XB_TOP], 1u);
            const unsigned tg = og / nx;
            if (og + 1u == (tg + 1u) * nx) xb_add(&bar[XB_TOPGEN], 1u);
            else XB_SPIN(xb_ld(&bar[XB_TOPGEN]) == tg, bar);
            __builtin_amdgcn_fence(__ATOMIC_ACQUIRE, "agent");
            xb_add(&bar[XB_XGEN(b.x)], 1u);
            asm volatile("s_waitcnt vmcnt(0)" ::: "memory");
        } else {
            XB_SPIN(xb_ld(&bar[XB_XGEN(b.x)]) == gen, bar);
            __builtin_amdgcn_fence(__ATOMIC_ACQUIRE, "agent");
            asm volatile("s_waitcnt vmcnt(0)" ::: "memory");
        }
    }
    __syncthreads();
}

__device__ __forceinline__ void grp_barrier(const XcdBarrier& b, const int wave_s) {
    asm volatile("s_waitcnt vmcnt(0)" ::: "memory");
    __syncthreads();
    if (wave_s == 0 && pg8::lane_id() == 0) {
        unsigned* bar = b.bar;
        __builtin_amdgcn_s_waitcnt(0);
        const unsigned nloc = b.st[0], nx = b.st[1], colo = b.st[2];
        const unsigned old = xb_add(&bar[XB_XSUB(b.x)], 1u);
        const unsigned gen = old / nloc;
        if (old + 1u == (gen + 1u) * nloc) {
            if (!colo) {
                __builtin_amdgcn_fence(__ATOMIC_RELEASE, "agent");
                asm volatile("s_waitcnt vmcnt(0)" ::: "memory");
                const unsigned og = xb_add(&bar[XB_TOP], 1u);
                const unsigned tg = og / nx;
                if (og + 1u == (tg + 1u) * nx) xb_add(&bar[XB_TOPGEN], 1u);
                else XB_SPIN(xb_ld(&bar[XB_TOPGEN]) == tg, bar);
            }
            __builtin_amdgcn_fence(__ATOMIC_ACQUIRE, "agent");
            xb_add(&bar[XB_XGEN(b.x)], 1u);
            asm volatile("s_waitcnt vmcnt(0)" ::: "memory");
        } else {
            XB_SPIN(xb_ld(&bar[XB_XGEN(b.x)]) == gen, bar);
            __builtin_amdgcn_fence(__ATOMIC_ACQUIRE, "agent");
            asm volatile("s_waitcnt vmcnt(0)" ::: "memory");
        }
    }
    __syncthreads();
}
__device__ __forceinline__ int opq_s(int x) { asm volatile("" : "+s"(x)); return x; }
typedef unsigned u32x4 __attribute__((ext_vector_type(4)));
typedef unsigned u32x2 __attribute__((ext_vector_type(2)));
template <int K> __device__ __forceinline__ float swz_xor(float v) { return __int_as_float(__builtin_amdgcn_ds_swizzle(__float_as_int(v), (K << 10) | 0x1f)); }
__device__ __forceinline__ float xor32(float v, bool mx) { auto rr = __builtin_amdgcn_permlane32_swap(__float_as_uint(v), __float_as_uint(v), false, false);
    const float a = __uint_as_float(rr[0]), b = __uint_as_float(rr[1]); return mx ? fmaxf(a, b) : a + b; }
template <int CTRL> __device__ __forceinline__ float dpp_x(float v) { return __int_as_float(__builtin_amdgcn_update_dpp(0, __float_as_int(v), CTRL, 0xf, 0xf, true)); }
__device__ __forceinline__ float xor16(float v, bool mx) { auto rr = __builtin_amdgcn_permlane16_swap(__float_as_uint(v), __float_as_uint(v), false, false);
    const float a = __uint_as_float(rr[0]), b = __uint_as_float(rr[1]); return mx ? fmaxf(a, b) : a + b; }
__device__ __forceinline__ float half_sum(float v) {
    v += dpp_x<0xB1>(v); v += dpp_x<0x4E>(v); v += dpp_x<0x141>(v); v += dpp_x<0x140>(v); return xor16(v, false);
}
__device__ __forceinline__ float wave_sum(float v) { return xor32(half_sum(v), false); }
__device__ __forceinline__ float wave_max(float v) {
    v = fmaxf(v, dpp_x<0xB1>(v)); v = fmaxf(v, dpp_x<0x4E>(v)); v = fmaxf(v, dpp_x<0x141>(v)); v = fmaxf(v, dpp_x<0x140>(v)); return xor32(xor16(v, true), true);
}
__device__ __forceinline__ float bflo(unsigned w) { return __uint_as_float(w << 16); }
__device__ __forceinline__ float bfhi(unsigned w) { return __uint_as_float(w & 0xffff0000u); }
__device__ __forceinline__ float bf2f(bf16 b) { return __uint_as_float((unsigned)b << 16); }
__device__ __forceinline__ void load_row_f32(const float* p, int lane, f32x4 (&v)[4]) {
#pragma unroll
    for (int j = 0; j < 4; ++j) v[j] = *(const f32x4*)(p + 4 * lane + 256 * j);
}
__device__ __forceinline__ void load_row_bf16(const bf16* p, int lane, f32x4 (&v)[4]) {
#pragma unroll
    for (int j = 0; j < 4; ++j) { const u32x2 w = *(const u32x2*)(p + 4 * lane + 256 * j); v[j] = (f32x4){bflo(w.x), bfhi(w.x), bflo(w.y), bfhi(w.y)}; }
}
__device__ __forceinline__ void store_row_bf16(bf16* p, int lane, const f32x4 (&v)[4]) {
#pragma unroll
    for (int j = 0; j < 4; ++j) { u32x2 w; w.x = pg8::cvt_pk_bf16(v[j][0], v[j][1]); w.y = pg8::cvt_pk_bf16(v[j][2], v[j][3]); *(u32x2*)(p + 4 * lane + 256 * j) = w; }
}
__device__ __forceinline__ void load_row8_f32(const float* p, int lane, f32x4 (&v)[4]) {
#pragma unroll
    for (int j = 0; j < 2; ++j) { v[2 * j] = *(const f32x4*)(p + 8 * lane + 512 * j); v[2 * j + 1] = *(const f32x4*)(p + 8 * lane + 512 * j + 4); }
}
__device__ __forceinline__ void load_row8_bf16(const bf16* p, int lane, f32x4 (&v)[4]) {
#pragma unroll
    for (int j = 0; j < 2; ++j) { const u32x4 w = *(const u32x4*)(p + 8 * lane + 512 * j); v[2 * j] = (f32x4){bflo(w.x), bfhi(w.x), bflo(w.y), bfhi(w.y)}; v[2 * j + 1] = (f32x4){bflo(w.z), bfhi(w.z), bflo(w.w), bfhi(w.w)}; }
}
__device__ __forceinline__ void store_row8_bf16(bf16* p, int lane, const f32x4 (&v)[4]) {
#pragma unroll
    for (int j = 0; j < 2; ++j) { u32x4 w; w.x = pg8::cvt_pk_bf16(v[2 * j][0], v[2 * j][1]); w.y = pg8::cvt_pk_bf16(v[2 * j][2], v[2 * j][3]); w.z = pg8::cvt_pk_bf16(v[2 * j + 1][0], v[2 * j + 1][1]); w.w = pg8::cvt_pk_bf16(v[2 * j + 1][2], v[2 * j + 1][3]);
        *(u32x4*)(p + 8 * lane + 512 * j) = w; }
}
__device__ __forceinline__ float row_ssq(const f32x4 (&v)[4]) {
    float s = 0.f;
#pragma unroll
    for (int j = 0; j < 4; ++j) s += (v[j][0] * v[j][0] + v[j][1] * v[j][1]) + (v[j][2] * v[j][2] + v[j][3] * v[j][3]);
    return wave_sum(s);
}
__device__ __forceinline__ float log_sigmoid(float x) { return fminf(x, 0.f) - log1pf(__expf(-fabsf(x))); }

enum { CK_ID = 0, CK_MLA_IN, CK_MLA_UQ, CK_MLA_UKV, CK_L_IN, CK_F_GU };
__device__ __forceinline__ int src_col(int kind, int n) {
    switch (kind) {
    case CK_MLA_IN: return n < MLA_IN ? n : -1;
    case CK_MLA_UQ: if (n < 1024) return 192 * (n >> 7) + (n & 127); else { const int r = n - 1024; return 192 * (r >> 6) + 128 + (r & 63); }
    case CK_MLA_UKV: if (n < 1024) return 256 * (n >> 7) + (n & 127); else { const int r = n - 1024; return 256 * (r >> 7) + 128 + (r & 127); }
    case CK_L_IN: if (n < 1024) return n; if (n < 2048) return 2048 + (n - 1024); if (n < 2560) return 512 + (n - 2048); return 1024 + (n - 2560);
    case CK_F_GU: { const int pn = n >> 8, half = (n >> 7) & 1; return half * DFF + 128 * pn + (n & 127); }
    default: return n;
    }
}
__device__ __forceinline__ void cvt_item(const float* W, int K, int Nsrc, int sc, bf16* WTrow0, LAS float* scr, int kb, int lane, const float* gk) {
    const int k0 = 64 * kb;
    f32x4 v[8];
    if (sc >= 0) { const float* src = W + (size_t)(k0 + lane) * Nsrc + sc; const float g = gk ? gk[k0 + lane] : 1.f;
#pragma unroll
        for (int i = 0; i < 8; ++i) v[i] = *(const f32x4*)(src + 4 * i) * g;
    } else {
#pragma unroll
        for (int i = 0; i < 8; ++i) v[i] = (f32x4){0.f, 0.f, 0.f, 0.f};
    }
#pragma unroll
    for (int i = 0; i < 8; ++i)
#pragma unroll
        for (int e = 0; e < 4; ++e) scr[(4 * i + e) * 68 + lane] = v[i][e];
    LDS_WAIT(); asm volatile("" ::: "memory");
    const int n = lane >> 1, half = lane & 1; const LAS float* s = scr + n * 68 + half * 32;
#pragma unroll
    for (int q = 0; q < 4; ++q) { const f32x4 a = *(const LAS f32x4*)(s + 8 * q), bq = *(const LAS f32x4*)(s + 8 * q + 4);
        u32x4 o; o.x = pg8::cvt_pk_bf16(a[0], a[1]); o.y = pg8::cvt_pk_bf16(a[2], a[3]); o.z = pg8::cvt_pk_bf16(bq[0], bq[1]); o.w = pg8::cvt_pk_bf16(bq[2], bq[3]);
        *(u32x4*)(WTrow0 + (size_t)n * K + k0 + half * 32 + 8 * q) = o; }
    LDS_WAIT(); asm volatile("" ::: "memory");
}

template <int D1, int D2, int DV>
__device__ __forceinline__ void naive_attn_row(const bf16* q1, const bf16* q2, const bf16* k1, size_t k1p, const bf16* k2, size_t k2p, int nk,
                                               const bf16* vt, size_t vtp, bf16* o, LAS float* qs, LAS float* sc, int lane) {
    for (int d = lane; d < D1; d += 64) qs[d] = bf2f(q1[d]);
    if (D2 > 0) for (int d = lane; d < D2; d += 64) qs[D1 + d] = bf2f(q2[d]);
    LDS_WAIT();
    float mx = -1e30f;
    const int nkr = (nk + 63) & ~63;
    for (int kb = 0; kb < nkr; kb += 64) {
        const int key = kb + lane; float s = -__builtin_inff();
        if (key < nk) {
            s = 0.f; const bf16* kr = k1 + (size_t)key * k1p;
            for (int c = 0; c < D1 / 8; ++c) { const u32x4 w = *(const u32x4*)(kr + 8 * c); const LAS float* q = qs + 8 * c;
                s += q[0] * bflo(w.x) + q[1] * bfhi(w.x) + q[2] * bflo(w.y) + q[3] * bfhi(w.y) + q[4] * bflo(w.z) + q[5] * bfhi(w.z) + q[6] * bflo(w.w) + q[7] * bfhi(w.w); }
            if (D2 > 0) { const bf16* kr2 = k2 + (size_t)key * k2p;
                for (int c = 0; c < D2 / 8; ++c) { const u32x4 w = *(const u32x4*)(kr2 + 8 * c); const LAS float* q = qs + D1 + 8 * c;
                    s += q[0] * bflo(w.x) + q[1] * bfhi(w.x) + q[2] * bflo(w.y) + q[3] * bfhi(w.y) + q[4] * bflo(w.z) + q[5] * bfhi(w.z) + q[6] * bflo(w.w) + q[7] * bfhi(w.w); } }
        }
        sc[key] = s; mx = fmaxf(mx, s);
    }
    mx = wave_max(mx);
    float sum = 0.f;
    LDS_WAIT();
    for (int kb = 0; kb < nkr; kb += 64) { const int key = kb + lane; const float p = exp2f(sc[key] - mx); sc[key] = p; sum += p; }
    sum = wave_sum(sum);
    LDS_WAIT();
    const float inv = 1.f / sum;
#pragma unroll
    for (int i = 0; i < DV / 64; ++i) { const int dv = lane + 64 * i; const bf16* vr = vt + (size_t)dv * vtp; float acc = 0.f;
        for (int kb = 0; kb < nkr; kb += 8) { const u32x4 w = *(const u32x4*)(vr + kb); const LAS float* p = sc + kb;
            acc += p[0] * bflo(w.x) + p[1] * bfhi(w.x) + p[2] * bflo(w.y) + p[3] * bfhi(w.y) + p[4] * bflo(w.z) + p[5] * bfhi(w.z) + p[6] * bflo(w.w) + p[7] * bfhi(w.w); }
        o[dv] = (bf16)(pg8::cvt_pk_bf16(acc * inv, 0.f) & 0xffffu); }
    LDS_WAIT();
}

__device__ __forceinline__ void naive_scan_unit(int unit, const bf16* QK, const bf16* KVT, const float* GATES, bf16* HS, LAS unsigned char* lds, int tid, int nchunks = SEQ / 64) {
    const int b = unit >> 4, h = (unit >> 2) & 3, vs = unit & 3;
    LAS float* ql = (LAS float*)lds; LAS float* kl = ql + 64 * 128; LAS float* vl = kl + 64 * 128; LAS float* gl = vl + 64 * 64;
    const int v = tid >> 3, dg = tid & 7;
    float C[16], n[16];
#pragma unroll
    for (int i = 0; i < 16; ++i) { C[i] = 0.f; n[i] = 0.f; }
    float m = 0.f;
    for (int c = 0; c < nchunks; ++c) {
        const size_t tok0 = (size_t)b * SEQ + (size_t)c * 64;
        __syncthreads();
#pragma unroll
        for (int i = 0; i < 2; ++i) { const int ch = tid + 512 * i, t = ch >> 4, c8 = ch & 15;
            const u32x4 wq = *(const u32x4*)(QK + (tok0 + t) * 1024 + h * 128 + c8 * 8); const u32x4 wk = *(const u32x4*)(QK + (tok0 + t) * 1024 + 512 + h * 128 + c8 * 8);
            LAS float* qd = ql + t * 128 + c8 * 8; LAS float* kd = kl + t * 128 + c8 * 8;
            qd[0] = bflo(wq.x); qd[1] = bfhi(wq.x); qd[2] = bflo(wq.y); qd[3] = bfhi(wq.y); qd[4] = bflo(wq.z); qd[5] = bfhi(wq.z); qd[6] = bflo(wq.w); qd[7] = bfhi(wq.w);
            kd[0] = bflo(wk.x); kd[1] = bfhi(wk.x); kd[2] = bflo(wk.y); kd[3] = bfhi(wk.y); kd[4] = bflo(wk.z); kd[5] = bfhi(wk.z); kd[6] = bflo(wk.w); kd[7] = bfhi(wk.w); }
        { const int row = tid >> 3, t8 = tid & 7; const u32x4 w = *(const u32x4*)(KVT + (size_t)(512 + h * 256 + vs * 64 + row) * M + tok0 + t8 * 8);
            LAS float* vd = vl + (t8 * 8) * 64 + row;
            vd[0 * 64] = bflo(w.x); vd[1 * 64] = bfhi(w.x); vd[2 * 64] = bflo(w.y); vd[3 * 64] = bfhi(w.y); vd[4 * 64] = bflo(w.z); vd[5 * 64] = bfhi(w.z); vd[6 * 64] = bflo(w.w); vd[7 * 64] = bfhi(w.w); }
        if (tid < 64) { gl[2 * tid] = GATES[(tok0 + tid) * 8 + h]; gl[2 * tid + 1] = log_sigmoid(GATES[(tok0 + tid) * 8 + 4 + h]); }
        __syncthreads();
        for (int t = 0; t < 64; ++t) {
            const float li = gl[2 * t], lf = gl[2 * t + 1];
            const float mn = fmaxf(lf + m, li), fw = __expf(lf + m - mn), iw = __expf(li - mn); m = mn;
            const float vv = vl[t * 64 + v] * iw;
            float num = 0.f, den = 0.f;
#pragma unroll
            for (int i = 0; i < 16; ++i) { const float kk = kl[t * 128 + dg + 8 * i], qq = ql[t * 128 + dg + 8 * i];
                C[i] = fw * C[i] + vv * kk; n[i] = fw * n[i] + iw * kk; num += C[i] * qq; den += n[i] * qq; }
            num += swz_xor<1>(num); den += swz_xor<1>(den); num += swz_xor<2>(num); den += swz_xor<2>(den); num += swz_xor<4>(num); den += swz_xor<4>(den);
            if (dg == 0) { const float hv = num / fmaxf(fabsf(den), __expf(-m)); HS[(tok0 + t) * 1024 + h * 256 + vs * 64 + v] = (bf16)(pg8::cvt_pk_bf16(hv, 0.f) & 0xffffu); }
        }
    }
}
typedef float f32x16 __attribute__((ext_vector_type(16)));
typedef short s16x8 __attribute__((ext_vector_type(8)));
constexpr int AT_KROW = 400, AT_VROW = 136, AT_KBYTES = 64 * AT_KROW, AT_VBYTES = 128 * AT_VROW, AT_STAGE = AT_KBYTES + AT_VBYTES;
__device__ __forceinline__ s16x8 pack_p8(const f32x16& p, int b0) {
    u32x4 w; w.x = pg8::cvt_pk_bf16(p[b0 + 0], p[b0 + 1]); w.y = pg8::cvt_pk_bf16(p[b0 + 2], p[b0 + 3]); w.z = pg8::cvt_pk_bf16(p[b0 + 4], p[b0 + 5]); w.w = pg8::cvt_pk_bf16(p[b0 + 6], p[b0 + 7]);
    return __builtin_bit_cast(s16x8, w);
}
__device__ __forceinline__ void mla_attn_unit(int b, int h, int qb, const bf16* QN, const bf16* QR, const bf16* KN, const bf16* KR, const bf16* VT, const float* COS, const float* SIN, bf16* O, LAS unsigned char* lds, int tid) {
    const int lane = tid & 63, wid = __builtin_amdgcn_readfirstlane(tid >> 6), r32 = lane & 31, hh = lane >> 5;
    const size_t tok0 = (size_t)b * SEQ;
    const size_t qrow = tok0 + (size_t)qb * 256 + 32 * wid + r32;
    const int NT = 4 * qb + 4;
    constexpr int AT_KSLOT = 24 * 1024, AT_VBASE = 3 * AT_KSLOT, AT_VSLOT = 16 * 1024;
    static_assert(AT_VBASE + 4 * AT_VSLOT <= RING_BYTES, "attention LDS map");
    const int r32s = (r32 & ~0xC) | ((r32 & 4) << 1) | ((r32 & 8) >> 1);
    const bf16* gkn = KN + (tok0 + r32s) * 1024 + h * 128 + 8 * hh;
    const bf16* gkr = KR + (tok0 + r32s) * 64 + 8 * hh;
    const bf16* gvt = VT + (size_t)(h * 128 + r32) * VT_LD + tok0 + 8 * hh;
    const bf16* p0 = gkn + 16 * wid;
    const bf16* p1 = (wid < 4) ? gkr + 16 * wid : gkn + (size_t)32 * 1024 + 16 * (wid - 4);
    const bf16* p2 = (wid < 4) ? gkn + (size_t)32 * 1024 + 16 * (wid + 4) : gkr + 32 * 64 + 16 * (wid - 4);
    const bf16* p3 = gvt + (size_t)(32 * (wid >> 2)) * VT_LD + 32 * ((wid >> 1) & 1) + 16 * (wid & 1);
    const bf16* p4 = p3 + (size_t)64 * VT_LD;
    const int st1 = (wid < 4) ? 64 * 64 : 64 * 1024, st2 = (wid < 4) ? 64 * 1024 : 64 * 64;
#define AT_ISSUE(t) do { const int t_ = (t); LAS unsigned char* d_ = lds + (t_ % 3) * AT_KSLOT + wid * 1024; LAS unsigned char* e_ = lds + AT_VBASE + (t_ & 3) * AT_VSLOT + wid * 1024; \
        __builtin_amdgcn_global_load_lds((const unsigned*)(p0 + (size_t)t_ * 65536), (LAS unsigned*)d_, 16, 0, 0); \
        __builtin_amdgcn_global_load_lds((const unsigned*)(p1 + (size_t)t_ * st1), (LAS unsigned*)(d_ + 8192), 16, 0, 0); \
        __builtin_amdgcn_global_load_lds((const unsigned*)(p2 + (size_t)t_ * st2), (LAS unsigned*)(d_ + 16384), 16, 0, 0); \
        __builtin_amdgcn_global_load_lds((const unsigned*)(p3 + (size_t)t_ * 64), (LAS unsigned*)e_, 16, 0, 0); \
        __builtin_amdgcn_global_load_lds((const unsigned*)(p4 + (size_t)t_ * 64), (LAS unsigned*)(e_ + 8192), 16, 0, 0); } while (0)
#define DSR128(dst, addr, off) asm volatile("ds_read_b128 %0, %1 offset:%2" : "=v"(dst) : "v"(addr), "n"(off))
#define LGKM_WAIT4(n, a, b, c, d) asm volatile("s_waitcnt lgkmcnt(" #n ")" : "+v"(a), "+v"(b), "+v"(c), "+v"(d))
#define AT_QKB(SX, addr_, o_) do { s16x8 fa0, fa1, fa2, fa3, fb0, fb1, fb2, fb3; \
        DSR128(fa0, addr_, (o_) + 0); DSR128(fa1, addr_, (o_) + 1024); DSR128(fa2, addr_, (o_) + 2048); DSR128(fa3, addr_, (o_) + 3072); \
        DSR128(fb0, addr_, (o_) + 4096); DSR128(fb1, addr_, (o_) + 5120); DSR128(fb2, addr_, (o_) + 6144); DSR128(fb3, addr_, (o_) + 7168); \
        LGKM_WAIT4(4, fa0, fa1, fa2, fa3); \
        SX = __builtin_amdgcn_mfma_f32_32x32x16_bf16(fa0, qf[0], SX, 0, 0, 0); SX = __builtin_amdgcn_mfma_f32_32x32x16_bf16(fa1, qf[1], SX, 0, 0, 0); \
        SX = __builtin_amdgcn_mfma_f32_32x32x16_bf16(fa2, qf[2], SX, 0, 0, 0); SX = __builtin_amdgcn_mfma_f32_32x32x16_bf16(fa3, qf[3], SX, 0, 0, 0); \
        s16x8 fc0, fc1, fc2, fc3; \
        DSR128(fc0, addr_, (o_) + 8192); DSR128(fc1, addr_, (o_) + 9216); DSR128(fc2, addr_, (o_) + 10240); DSR128(fc3, addr_, (o_) + 11264); \
        LGKM_WAIT4(4, fb0, fb1, fb2, fb3); \
        SX = __builtin_amdgcn_mfma_f32_32x32x16_bf16(fb0, qf[4], SX, 0, 0, 0); SX = __builtin_amdgcn_mfma_f32_32x32x16_bf16(fb1, qf[5], SX, 0, 0, 0); \
        SX = __builtin_amdgcn_mfma_f32_32x32x16_bf16(fb2, qf[6], SX, 0, 0, 0); SX = __builtin_amdgcn_mfma_f32_32x32x16_bf16(fb3, qf[7], SX, 0, 0, 0); \
        LGKM_WAIT4(0, fc0, fc1, fc2, fc3); \
        SX = __builtin_amdgcn_mfma_f32_32x32x16_bf16(fc0, qf[8], SX, 0, 0, 0); SX = __builtin_amdgcn_mfma_f32_32x32x16_bf16(fc1, qf[9], SX, 0, 0, 0); \
        SX = __builtin_amdgcn_mfma_f32_32x32x16_bf16(fc2, qf[10], SX, 0, 0, 0); SX = __builtin_amdgcn_mfma_f32_32x32x16_bf16(fc3, qf[11], SX, 0, 0, 0); } while (0)
#define AT_PVB(PA, PB, kb_) do { \
        { s16x8 v0, v1, v2, v3; DSR128(v0, va, (0 + 2 * (kb_)) * 1024); DSR128(v1, va, (4 + 2 * (kb_)) * 1024); DSR128(v2, va, (8 + 2 * (kb_)) * 1024); DSR128(v3, va, (12 + 2 * (kb_)) * 1024); \
            LGKM_WAIT4(0, v0, v1, v2, v3); \
            o[0] = __builtin_amdgcn_mfma_f32_32x32x16_bf16(v0, PA, o[0], 0, 0, 0); o[1] = __builtin_amdgcn_mfma_f32_32x32x16_bf16(v1, PA, o[1], 0, 0, 0); \
            o[2] = __builtin_amdgcn_mfma_f32_32x32x16_bf16(v2, PA, o[2], 0, 0, 0); o[3] = __builtin_amdgcn_mfma_f32_32x32x16_bf16(v3, PA, o[3], 0, 0, 0); } \
        { s16x8 v0, v1, v2, v3; DSR128(v0, va, (1 + 2 * (kb_)) * 1024); DSR128(v1, va, (5 + 2 * (kb_)) * 1024); DSR128(v2, va, (9 + 2 * (kb_)) * 1024); DSR128(v3, va, (13 + 2 * (kb_)) * 1024); \
            LGKM_WAIT4(0, v0, v1, v2, v3); \
            o[0] = __builtin_amdgcn_mfma_f32_32x32x16_bf16(v0, PB, o[0], 0, 0, 0); o[1] = __builtin_amdgcn_mfma_f32_32x32x16_bf16(v1, PB, o[1], 0, 0, 0); \
            o[2] = __builtin_amdgcn_mfma_f32_32x32x16_bf16(v2, PB, o[2], 0, 0, 0); o[3] = __builtin_amdgcn_mfma_f32_32x32x16_bf16(v3, PB, o[3], 0, 0, 0); } } while (0)
    f32x16 o[4];
#pragma unroll
    for (int d = 0; d < 4; ++d)
#pragma unroll
        for (int r = 0; r < 16; ++r) o[d][r] = 0.f;
    float m_run = -1e30f, l_run = 0.f;
    f32x16 s0, s1;
    AT_ISSUE(0); AT_ISSUE(1);
    s16x8 qf[12];
#pragma unroll
    for (int s = 0; s < 8; ++s) qf[s] = *(const s16x8*)(QN + qrow * 1024 + h * 128 + 16 * s + 8 * hh);
#pragma unroll
    for (int s = 0; s < 4; ++s) qf[8 + s] = *(const s16x8*)(QR + qrow * 512 + h * 64 + 16 * s + 8 * hh);
#pragma unroll
    for (int s = 0; s < 2; ++s) {
        const float* cp = COS + qrow * 32 + 16 * s + 8 * hh; const float* sp = SIN + qrow * 32 + 16 * s + 8 * hh;
        const f32x4 c0 = *(const f32x4*)cp, c1 = *(const f32x4*)(cp + 4), s0 = *(const f32x4*)sp, s1 = *(const f32x4*)(sp + 4);
        const u32x4 xa = __builtin_bit_cast(u32x4, qf[8 + s]), xb = __builtin_bit_cast(u32x4, qf[10 + s]); u32x4 oa, ob;
#pragma unroll
        for (int w = 0; w < 4; ++w) { const float cl = w < 2 ? c0[2 * w] : c1[2 * w - 4], ch = w < 2 ? c0[2 * w + 1] : c1[2 * w - 3], sl = w < 2 ? s0[2 * w] : s1[2 * w - 4], sh = w < 2 ? s0[2 * w + 1] : s1[2 * w - 3];
            const float x1l = bflo(xa[w]), x1h = bfhi(xa[w]), x2l = bflo(xb[w]), x2h = bfhi(xb[w]);
            oa[w] = pg8::cvt_pk_bf16(x1l * cl - x2l * sl, x1h * ch - x2h * sh); ob[w] = pg8::cvt_pk_bf16(x2l * cl + x1l * sl, x2h * ch + x1h * sh); }
        qf[8 + s] = __builtin_bit_cast(s16x8, oa); qf[10 + s] = __builtin_bit_cast(s16x8, ob); }
    asm volatile("s_waitcnt vmcnt(0)" ::: "memory");
    const bool late = wid >= 4; bool pact0 = false, pact1 = false;
    s16x8 pa0 = {0, 0, 0, 0, 0, 0, 0, 0}, pb0 = pa0, pa1 = pa0, pb1 = pa0;
    for (int t = 0; t < NT; ++t) {
        if (t + 1 < NT) asm volatile("s_waitcnt vmcnt(5)" ::: "memory"); else asm volatile("s_waitcnt vmcnt(0)" ::: "memory");
        asm volatile("s_waitcnt lgkmcnt(0)\n\ts_barrier" ::: "memory");
        if (t + 2 < NT) AT_ISSUE(t + 2);
        int sa = (t % 3) * AT_KSLOT + lane * 16; asm volatile("" : "+v"(sa));
        if (late && t > 0) { int va = AT_VBASE + ((t - 1) & 3) * AT_VSLOT + lane * 16; asm volatile("" : "+v"(va)); if (pact0) AT_PVB(pa0, pb0, 0); if (pact1) AT_PVB(pa1, pb1, 1); }
        const int jj = t - 4 * qb;
        const bool act0 = (jj < 0) || (2 * jj <= wid), act1 = (jj < 0) || (2 * jj + 1 <= wid);
#pragma unroll
        for (int r = 0; r < 16; ++r) { s0[r] = 0.f; s1[r] = 0.f; }
        if (act0) AT_QKB(s0, sa, 0);
        if (act1) AT_QKB(s1, sa, 12 * 1024);
        const float NEG = -__builtin_inff();
        if (jj >= 0) {
            const int d0 = 32 * wid + r32 - 64 * jj - 8 * hh;
#pragma unroll
            for (int r = 0; r < 16; ++r) { const int c = (r & 3) + 4 * ((r >> 2) & 1) + 16 * (r >> 3); if (c > d0) s0[r] = NEG; if (c + 32 > d0) s1[r] = NEG; }
        }
        float mx = fmaxf(s0[0], s1[0]);
#pragma unroll
        for (int r = 1; r < 16; ++r) mx = fmaxf(mx, fmaxf(s0[r], s1[r]));
        mx = xor32(mx, true);
        if (__builtin_amdgcn_ballot_w64(mx > m_run + 8.f) != 0ull) {
            const float m_new = fmaxf(m_run, mx), alpha = __builtin_amdgcn_exp2f(m_run - m_new); m_run = m_new; l_run *= alpha;
#pragma unroll
            for (int d = 0; d < 4; ++d)
#pragma unroll
                for (int r = 0; r < 16; ++r) o[d][r] *= alpha;
        }
        float ps = 0.f;
#pragma unroll
        for (int r = 0; r < 16; ++r) { s0[r] = __builtin_amdgcn_exp2f(s0[r] - m_run); s1[r] = __builtin_amdgcn_exp2f(s1[r] - m_run); ps += s0[r] + s1[r]; }
        l_run += ps;
        pa0 = pack_p8(s0, 0); pb0 = pack_p8(s0, 8); pa1 = pack_p8(s1, 0); pb1 = pack_p8(s1, 8);
        if (!late) { int va = AT_VBASE + (t & 3) * AT_VSLOT + lane * 16; asm volatile("" : "+v"(va)); if (act0) AT_PVB(pa0, pb0, 0); if (act1) AT_PVB(pa1, pb1, 1); }
        else { pact0 = act0; pact1 = act1; }
    }
    if (late) { int va = AT_VBASE + ((NT - 1) & 3) * AT_VSLOT + lane * 16; asm volatile("" : "+v"(va)); if (pact0) AT_PVB(pa0, pb0, 0); if (pact1) AT_PVB(pa1, pb1, 1); }
    asm volatile("s_waitcnt lgkmcnt(0)\n\ts_barrier" ::: "memory");
    const float inv = 1.f / xor32(l_run, false);
    LAS unsigned char* st = lds + wid * (32 * 144);
    bf16* obase = O + (tok0 + (size_t)qb * 256 + 32 * wid) * 1024 + h * 128;
#pragma unroll
    for (int half = 0; half < 2; ++half) {
#pragma unroll
        for (int dd = 0; dd < 2; ++dd)
#pragma unroll
            for (int g = 0; g < 4; ++g) { const int d = 2 * half + dd; u32x2 w; w.x = pg8::cvt_pk_bf16(o[d][4 * g] * inv, o[d][4 * g + 1] * inv); w.y = pg8::cvt_pk_bf16(o[d][4 * g + 2] * inv, o[d][4 * g + 3] * inv);
                *(LAS u32x2*)(st + r32 * 144 + (32 * dd + 8 * g + 4 * hh) * 2) = w; }
        asm volatile("s_waitcnt lgkmcnt(0)" ::: "memory");
#pragma unroll
        for (int i = 0; i < 4; ++i) { const int id = i * 64 + lane, row = id >> 3, ch = id & 7; const u32x4 v = *(const LAS u32x4*)(st + row * 144 + ch * 16);
            *(u32x4*)(obase + (size_t)row * 1024 + 64 * half + ch * 8) = v; }
        asm volatile("s_waitcnt lgkmcnt(0)" ::: "memory");
    }
    asm volatile("s_waitcnt vmcnt(0) lgkmcnt(0)\n\ts_barrier" ::: "memory");
#undef AT_ISSUE
#undef AT_QKB
#undef AT_PVB
#undef DSR128
#undef LGKM_WAIT4
}
constexpr int XA_KROW = 528, XA_KBYTES = 64 * XA_KROW, XA_VROW = 136, XA_STAGE = XA_KBYTES;
__device__ __forceinline__ void mem_attn_unit(int pm, int h, const bf16* QM, const bf16* KMl, const bf16* VMTl, bf16* O, LAS unsigned char* lds, int tid) {
    const int lane = tid & 63, wid = __builtin_amdgcn_readfirstlane(tid >> 6), r32 = lane & 31, hh = lane >> 5;
    const int b = pm >> 3;
    const size_t qrow = (size_t)pm * 256 + 32 * wid + r32;
    const bf16* gk = KMl + ((size_t)b * NMEM + (tid >> 5)) * 1024 + h * 256 + (tid & 31) * 8;
    const bf16* gv = VMTl + (size_t)(h * 256 + (tid >> 3)) * VMT_LD + (size_t)b * NMEM + (tid & 7) * 8;
    const int lk = (tid >> 5) * XA_KROW + (tid & 31) * 16, lv = (tid >> 3) * XA_VROW + (tid & 7) * 16;
    u32x4 sa0, sa1, sa2, sa3, sb0, sb1, sb2, sb3;
#define XA_LOAD(P, st) do { if ((st) < 4) { const bf16* p_ = gk + (size_t)(64 * (st)) * 1024; P##0 = *(const u32x4*)p_; P##1 = *(const u32x4*)(p_ + 16 * 1024); P##2 = *(const u32x4*)(p_ + 32 * 1024); P##3 = *(const u32x4*)(p_ + 48 * 1024); } \
                         else { const bf16* p_ = gv + (size_t)(128 * (((st) - 4) >> 2)) * VMT_LD + 64 * (((st) - 4) & 3); P##0 = *(const u32x4*)p_; P##1 = *(const u32x4*)(p_ + (size_t)64 * VMT_LD); } } while (0)
#define XA_WRITE(P, st, bo) do { if ((st) < 4) { *(LAS u32x4*)(lds + (bo) + lk) = P##0; *(LAS u32x4*)(lds + (bo) + lk + 16 * XA_KROW) = P##1; *(LAS u32x4*)(lds + (bo) + lk + 32 * XA_KROW) = P##2; *(LAS u32x4*)(lds + (bo) + lk + 48 * XA_KROW) = P##3; } \
                              else { *(LAS u32x2*)(lds + (bo) + lv) = (u32x2){(P##0).x, (P##0).y}; *(LAS u32x2*)(lds + (bo) + lv + 8) = (u32x2){(P##0).z, (P##0).w}; \
                                     *(LAS u32x2*)(lds + (bo) + lv + 64 * XA_VROW) = (u32x2){(P##1).x, (P##1).y}; *(LAS u32x2*)(lds + (bo) + lv + 64 * XA_VROW + 8) = (u32x2){(P##1).z, (P##1).w}; } } while (0)
    f32x16 S[8]; s16x8 P[8][2]; f32x16 o[4]; float linv = 0.f;
    const int ka = r32 * XA_KROW + 16 * hh, va = r32 * XA_VROW + 8 * hh;
    XA_LOAD(sa, 0); XA_LOAD(sb, 1);
    s16x8 qf[16];
#pragma unroll
    for (int s = 0; s < 16; ++s) qf[s] = *(const s16x8*)(QM + qrow * 1024 + h * 256 + 16 * s + 8 * hh);
    XA_WRITE(sa, 0, 0); __syncthreads();
#pragma unroll
    for (int st = 0; st < 12; ++st) {
        const int bo = (st & 1) * XA_STAGE;
        if (st + 2 < 12) { if ((st & 1) == 0) XA_LOAD(sa, st + 2); else XA_LOAD(sb, st + 2); }
        if (st < 4) {
#pragma unroll
            for (int kb = 0; kb < 2; ++kb) { f32x16 acc;
#pragma unroll
                for (int r = 0; r < 16; ++r) acc[r] = 0.f;
#pragma unroll
                for (int s = 0; s < 16; ++s) { const s16x8 a = *(const LAS s16x8*)(lds + bo + ka + 32 * kb * XA_KROW + 32 * s); acc = __builtin_amdgcn_mfma_f32_32x32x16_bf16(a, qf[s], acc, 0, 0, 0); }
                S[2 * st + kb] = acc; }
            if (st == 3) {
                float mx = S[0][0];
#pragma unroll
                for (int i = 0; i < 8; ++i)
#pragma unroll
                    for (int r = 0; r < 16; ++r) mx = fmaxf(mx, S[i][r]);
                mx = xor32(mx, true);
                float ps = 0.f;
#pragma unroll
                for (int i = 0; i < 8; ++i) {
#pragma unroll
                    for (int r = 0; r < 16; ++r) { S[i][r] = __builtin_amdgcn_exp2f(S[i][r] - mx); ps += S[i][r]; }
                    P[i][0] = pack_p8(S[i], 0); P[i][1] = pack_p8(S[i], 8); }
                linv = 1.f / xor32(ps, false);
            }
        } else {
            const int t = (st - 4) & 3, dvh = (st - 4) >> 2;
            if (t == 0) {
#pragma unroll
                for (int d = 0; d < 4; ++d)
#pragma unroll
                    for (int r = 0; r < 16; ++r) o[d][r] = 0.f; }
#pragma unroll
            for (int kb = 0; kb < 2; ++kb)
#pragma unroll
                for (int s2 = 0; s2 < 2; ++s2)
#pragma unroll
                    for (int d = 0; d < 4; ++d) { const u32x2 lo = *(const LAS u32x2*)(lds + bo + va + 32 * d * XA_VROW + 64 * kb + 32 * s2), hi = *(const LAS u32x2*)(lds + bo + va + 32 * d * XA_VROW + 64 * kb + 32 * s2 + 16);
                        const u32x4 aw = (u32x4){lo.x, lo.y, hi.x, hi.y}; o[d] = __builtin_amdgcn_mfma_f32_32x32x16_bf16(__builtin_bit_cast(s16x8, aw), P[2 * t + kb][s2], o[d], 0, 0, 0); }
            if (t == 3) {
                int ln2 = lane; asm volatile("" : "+v"(ln2)); const int r32 = ln2 & 31, hh = ln2 >> 5;
                LAS unsigned char* stg = lds + 2 * XA_STAGE + wid * (32 * 272); bf16* obase = O + ((size_t)pm * 256 + 32 * wid) * 1024 + h * 256 + 128 * dvh;
#pragma unroll
                for (int d = 0; d < 4; ++d)
#pragma unroll
                    for (int g = 0; g < 4; ++g) { u32x2 w; w.x = pg8::cvt_pk_bf16(o[d][4 * g] * linv, o[d][4 * g + 1] * linv); w.y = pg8::cvt_pk_bf16(o[d][4 * g + 2] * linv, o[d][4 * g + 3] * linv);
                        *(LAS u32x2*)(stg + r32 * 272 + (32 * d + 8 * g + 4 * hh) * 2) = w; }
                asm volatile("s_waitcnt lgkmcnt(0)" ::: "memory");
#pragma unroll
                for (int i = 0; i < 8; ++i) { const int id = i * 64 + lane, row = id >> 4, ch = id & 15; const u32x4 v = *(const LAS u32x4*)(stg + row * 272 + ch * 16);
                    *(u32x4*)(obase + (size_t)row * 1024 + ch * 8) = v; }
                asm volatile("s_waitcnt lgkmcnt(0)" ::: "memory"); }
        }
        if (st + 1 < 12) { if ((st & 1) == 0) XA_WRITE(sb, st + 1, XA_STAGE); else XA_WRITE(sa, st + 1, 0); }
        __syncthreads();
    }
#undef XA_LOAD
#undef XA_WRITE
}
constexpr int SC_QROW = 272, SC_TROW = 144;
constexpr int SC_QT = 0, SC_KT = SC_QT + 64 * SC_QROW, SC_VTW = SC_KT + 64 * SC_QROW, SC_VT = SC_VTW + 96 * SC_TROW, SC_P = SC_VT + 96 * SC_TROW, SC_CB = SC_P + 64 * SC_TROW,
              SC_CBSZ = 96 * SC_QROW, SC_GA = SC_CB + 2 * SC_CBSZ, SC_GASZ = 1536, SC_DEN = SC_GA + 2 * SC_GASZ, SC_HS = SC_DEN + 256, SC_END = SC_HS + 64 * 128;
static_assert(SC_END <= RING_BYTES, "scan LDS map");
template <int CTRL> __device__ __forceinline__ float dpp_f(float oldv, float v) { return __int_as_float(__builtin_amdgcn_update_dpp(__float_as_int(oldv), __float_as_int(v), CTRL, 0xf, 0xf, false)); }
__device__ __forceinline__ float rdlane(float v, int l) { return __int_as_float(__builtin_amdgcn_readlane(__float_as_int(v), l)); }
__device__ __forceinline__ float scan_gates(const float li, const float fg, float m, LAS float* ga, int lane) {
    const float lf = log_sigmoid(fg);
    float v = lf;
    v += dpp_f<0x111>(0.f, v); v += dpp_f<0x112>(0.f, v); v += dpp_f<0x114>(0.f, v); v += dpp_f<0x118>(0.f, v);
    { const float t0 = rdlane(v, 15), t1 = rdlane(v, 31), t2 = rdlane(v, 47); const int row = lane >> 4; v += (row >= 1 ? t0 : 0.f) + (row >= 2 ? t1 : 0.f) + (row >= 3 ? t2 : 0.f); }
    const float b = v, a = li - b;
    const float NEG = -__builtin_inff();
    float p = a;
    p = fmaxf(p, dpp_f<0x111>(NEG, p)); p = fmaxf(p, dpp_f<0x112>(NEG, p)); p = fmaxf(p, dpp_f<0x114>(NEG, p)); p = fmaxf(p, dpp_f<0x118>(NEG, p));
    { const float t0 = rdlane(p, 15), t1 = rdlane(p, 31), t2 = rdlane(p, 47); const int row = lane >> 4;
      float o = NEG; if (row >= 1) o = t0; if (row >= 2) o = fmaxf(o, t1); if (row >= 3) o = fmaxf(o, t2); p = fmaxf(p, o); }
    const float mt = b + fmaxf(m, p);
    const float b_last = rdlane(b, 63), m_new = rdlane(mt, 63);
    ga[lane] = __expf(b_last - m_new + a); ga[64 + lane] = a; ga[128 + lane] = b - mt; ga[192 + lane] = __expf(b + m - mt); ga[256 + lane] = __expf(-mt);
    if (lane == 0) ga[320] = __expf(b_last + m - m_new);
    return m_new;
}
__device__ __forceinline__ void mlstm_scan_unit(int unit, const bf16* QK, const bf16* KVT, const float* GATES, bf16* HS, LAS unsigned char* lds, int tid) {
    const int b = unit >> 4, h = (unit >> 2) & 3, vs = unit & 3;
    const int lane = tid & 63, wid = __builtin_amdgcn_readfirstlane(tid >> 6), r32 = lane & 31, hh = lane >> 5;
    const size_t tokb = (size_t)b * SEQ;
    const __amdgpu_buffer_rsrc_t rQ = __builtin_amdgcn_make_buffer_rsrc((void*)(QK + tokb * 1024 + h * 128), 0, 0x7fffffff, 0x00020000);
    const __amdgpu_buffer_rsrc_t rV = __builtin_amdgcn_make_buffer_rsrc((void*)(KVT + (size_t)(h * 256 + vs * 64) * KVT_LD + tokb), 0, 0x7fffffff, 0x00020000);
    const int vq = ((tid >> 4) * 1024 + (tid & 15) * 8) * 2, vt = (int)(((size_t)(tid >> 3) * KVT_LD + (tid & 7) * 8) * 2);
    const int lq = (tid >> 4) * SC_QROW + (tid & 15) * 16, lt = (tid >> 3) * SC_TROW + (tid & 7) * 16;
    u32x4 aq0, aq1, ak0, ak1, av0, bq0, bq1, bk0, bk1, bv0;
#define SC_BL(r_, v_, s_) __builtin_bit_cast(u32x4, __builtin_amdgcn_raw_buffer_load_b128(r_, v_, s_, 0))
#define SC_LOAD(P, c) do { const int sq_ = (c) * (64 * 1024 * 2), st_ = (c) * 128; P##q0 = SC_BL(rQ, vq, sq_); P##q1 = SC_BL(rQ, vq, sq_ + 32 * 1024 * 2); P##k0 = SC_BL(rQ, vq, sq_ + 1024); P##k1 = SC_BL(rQ, vq, sq_ + 32 * 1024 * 2 + 1024); \
        P##v0 = SC_BL(rV, vt, st_); } while (0)
#define SC_SCALE8(V_, wkp) do { const f32x4 a_ = *(const LAS f32x4*)(wkp), b_ = *(const LAS f32x4*)((wkp) + 4); u32x4 n_; \
        n_.x = pg8::cvt_pk_bf16(bflo(V_.x) * a_[0], bfhi(V_.x) * a_[1]); n_.y = pg8::cvt_pk_bf16(bflo(V_.y) * a_[2], bfhi(V_.y) * a_[3]); n_.z = pg8::cvt_pk_bf16(bflo(V_.z) * b_[0], bfhi(V_.z) * b_[1]); n_.w = pg8::cvt_pk_bf16(bflo(V_.w) * b_[2], bfhi(V_.w) * b_[3]); V_ = n_; } while (0)
#define SC_WRITE(P, gab) do { *(LAS u32x4*)(lds + SC_QT + lq) = P##q0; *(LAS u32x4*)(lds + SC_QT + lq + 32 * SC_QROW) = P##q1; *(LAS u32x4*)(lds + SC_KT + lq) = P##k0; *(LAS u32x4*)(lds + SC_KT + lq + 32 * SC_QROW) = P##k1; \
        { const LAS float* wkp_ = (const LAS float*)(lds + SC_GA + (gab) * SC_GASZ) + (tid & 7) * 8; u32x4 vw_ = P##v0; SC_SCALE8(vw_, wkp_); *(LAS u32x4*)(lds + SC_VTW + lt) = vw_; \
          if (tid < 8) { const f32x4 a_ = *(const LAS f32x4*)(wkp_), b_ = *(const LAS f32x4*)(wkp_ + 4); u32x4 n_; n_.x = pg8::cvt_pk_bf16(a_[0], a_[1]); n_.y = pg8::cvt_pk_bf16(a_[2], a_[3]); n_.z = pg8::cvt_pk_bf16(b_[0], b_[1]); n_.w = pg8::cvt_pk_bf16(b_[2], b_[3]); \
              *(LAS u32x4*)(lds + SC_VTW + 64 * SC_TROW + tid * 16) = n_; } } \
        *(LAS u32x4*)(lds + SC_VT + lt) = P##v0; } while (0)
    SC_LOAD(a, 0);
    for (int i = tid; i < 32 * SC_TROW / 4; i += NWAVES * 64) ((LAS unsigned*)(lds + SC_VT + 64 * SC_TROW))[i] = (i < SC_TROW / 4) ? 0x3f803f80u : 0u;
    for (int i = tid; i < SC_CBSZ / 4; i += NWAVES * 64) ((LAS unsigned*)(lds + SC_CB))[i] = 0u;
    for (int i = tid; i < 32 * SC_TROW / 4; i += NWAVES * 64) ((LAS unsigned*)(lds + SC_VTW + 64 * SC_TROW))[i] = 0u;
    float m_run = 0.f, gli = 0.f, gfg = 0.f;
    if (wid == 7) { const float l0 = GATES[(tokb + lane) * 8 + h], f0 = GATES[(tokb + lane) * 8 + 4 + h]; gli = GATES[(tokb + 64 + lane) * 8 + h]; gfg = GATES[(tokb + 64 + lane) * 8 + 4 + h];
        m_run = scan_gates(l0, f0, 0.f, (LAS float*)(lds + SC_GA), lane); }
    __syncthreads();
    SC_WRITE(a, 0); SC_LOAD(b, 1);
    __syncthreads();
    f32x16 cacc[2], acc;
#pragma unroll
    for (int r = 0; r < 16; ++r) { cacc[0][r] = 0.f; cacc[1][r] = 0.f; acc[r] = 0.f; }
    const int tb = wid & 1, vb = wid >> 1;
    typedef short s16x4 __attribute__((ext_vector_type(4)));
    int ktb = SC_KT + (8 * hh + ((lane >> 2) & 3)) * SC_QROW + (64 * tb + 16 * ((lane >> 4) & 1) + 4 * (lane & 3)) * 2; asm volatile("" : "+v"(ktb));
#define SC_TR(dst, addr, off) asm volatile("ds_read_b64_tr_b16 %0, %1 offset:%2" : "=&v"(dst) : "v"(addr), "n"(off) : "memory")
    for (int c2 = 0; c2 < SEQ / 64; c2 += 2) {
#pragma unroll
      for (int par = 0; par < 2; ++par) { const int c = c2 + par;
        const size_t tok0 = tokb + (size_t)c * 64;
        const int gab = par; const LAS float* ga = (const LAS float*)(lds + SC_GA + gab * SC_GASZ);
        const int cbo = SC_CB + gab * SC_CBSZ, cbn = SC_CB + (gab ^ 1) * SC_CBSZ;
        if (c + 2 < SEQ / 64) { if (par == 0) SC_LOAD(a, c + 2); else SC_LOAD(b, c + 2); }
        if (c + 1 < SEQ / 64 && wid == 7) { m_run = scan_gates(gli, gfg, m_run, (LAS float*)(lds + SC_GA + (gab ^ 1) * SC_GASZ), lane);
            if (c + 2 < SEQ / 64) { gli = GATES[(tok0 + 128 + lane) * 8 + h]; gfg = GATES[(tok0 + 128 + lane) * 8 + 4 + h]; } }
        if (wid < 6) {
#pragma unroll
            for (int r = 0; r < 16; ++r) acc[r] = 0.f;
#pragma unroll
            for (int s = 0; s < 8; ++s) { const s16x8 a = *(const LAS s16x8*)(lds + SC_QT + (32 * tb + r32) * SC_QROW + 32 * s + 16 * hh), bb = *(const LAS s16x8*)(lds + cbo + (32 * vb + r32) * SC_QROW + 32 * s + 16 * hh);
                acc = __builtin_amdgcn_mfma_f32_32x32x16_bf16(a, bb, acc, 0, 0, 0); }
#pragma unroll
            for (int r = 0; r < 16; ++r) acc[r] *= ga[192 + 32 * tb + (r & 3) + 8 * (r >> 2) + 4 * hh];
            const float decay = ga[320];
#pragma unroll
            for (int i = 0; i < 2; ++i) { const int db = 2 * tb + i; (void)db;
#pragma unroll
                for (int r = 0; r < 16; ++r) cacc[i][r] *= decay;
                s16x4 kl0, kl1, kl2, kl3, kh0, kh1, kh2, kh3; int kta = ktb + i * 64; asm volatile("" : "+v"(kta));
                SC_TR(kl0, kta, 0 * 16 * SC_QROW); SC_TR(kh0, kta, 0 * 16 * SC_QROW + 4 * SC_QROW); SC_TR(kl1, kta, 1 * 16 * SC_QROW); SC_TR(kh1, kta, 1 * 16 * SC_QROW + 4 * SC_QROW);
                SC_TR(kl2, kta, 2 * 16 * SC_QROW); SC_TR(kh2, kta, 2 * 16 * SC_QROW + 4 * SC_QROW); SC_TR(kl3, kta, 3 * 16 * SC_QROW); SC_TR(kh3, kta, 3 * 16 * SC_QROW + 4 * SC_QROW);
                asm volatile("s_waitcnt lgkmcnt(0)" : "+v"(kl0), "+v"(kh0), "+v"(kl1), "+v"(kh1), "+v"(kl2), "+v"(kh2), "+v"(kl3), "+v"(kh3));
#define SC_CAT(lo_, hi_) __builtin_shufflevector(lo_, hi_, 0, 1, 2, 3, 4, 5, 6, 7)
                { const s16x8 bb = *(const LAS s16x8*)(lds + SC_VTW + (32 * vb + r32) * SC_TROW + 32 * 0 + 16 * hh); cacc[i] = __builtin_amdgcn_mfma_f32_32x32x16_bf16(SC_CAT(kl0, kh0), bb, cacc[i], 0, 0, 0); }
                { const s16x8 bb = *(const LAS s16x8*)(lds + SC_VTW + (32 * vb + r32) * SC_TROW + 32 * 1 + 16 * hh); cacc[i] = __builtin_amdgcn_mfma_f32_32x32x16_bf16(SC_CAT(kl1, kh1), bb, cacc[i], 0, 0, 0); }
                { const s16x8 bb = *(const LAS s16x8*)(lds + SC_VTW + (32 * vb + r32) * SC_TROW + 32 * 2 + 16 * hh); cacc[i] = __builtin_amdgcn_mfma_f32_32x32x16_bf16(SC_CAT(kl2, kh2), bb, cacc[i], 0, 0, 0); }
                { const s16x8 bb = *(const LAS s16x8*)(lds + SC_VTW + (32 * vb + r32) * SC_TROW + 32 * 3 + 16 * hh); cacc[i] = __builtin_amdgcn_mfma_f32_32x32x16_bf16(SC_CAT(kl3, kh3), bb, cacc[i], 0, 0, 0); }
#undef SC_CAT
#pragma unroll
                for (int g = 0; g < 4; ++g) { u32x2 w; w.x = pg8::cvt_pk_bf16(cacc[i][4 * g], cacc[i][4 * g + 1]); w.y = pg8::cvt_pk_bf16(cacc[i][4 * g + 2], cacc[i][4 * g + 3]);
                    *(LAS u32x2*)(lds + cbn + (32 * vb + r32) * SC_QROW + (32 * db + 8 * g + 4 * hh) * 2) = w; } }
        } else {
#pragma unroll
            for (int i = 0; i < 2; ++i) { if (wid == 7 && i == 1) break;
                const int sb = (wid == 6) ? i : 0, tb2 = (wid == 6) ? i : 1;
                f32x16 st;
#pragma unroll
                for (int r = 0; r < 16; ++r) st[r] = 0.f;
#pragma unroll
                for (int s = 0; s < 8; ++s) { const s16x8 a = *(const LAS s16x8*)(lds + SC_KT + (32 * sb + r32) * SC_QROW + 32 * s + 16 * hh), bb = *(const LAS s16x8*)(lds + SC_QT + (32 * tb2 + r32) * SC_QROW + 32 * s + 16 * hh);
                    st = __builtin_amdgcn_mfma_f32_32x32x16_bf16(a, bb, st, 0, 0, 0); }
                const float bmt = ga[128 + 32 * tb2 + r32];
#pragma unroll
                for (int r = 0; r < 16; ++r) { const int cr = (r & 3) + 8 * (r >> 2) + 4 * hh; const float w = __expf(bmt + ga[64 + 32 * sb + cr]);
                    st[r] = (sb < tb2 || cr <= r32) ? st[r] * w : 0.f; }
#pragma unroll
                for (int g = 0; g < 4; ++g) { u32x2 w; w.x = pg8::cvt_pk_bf16(st[4 * g], st[4 * g + 1]); w.y = pg8::cvt_pk_bf16(st[4 * g + 2], st[4 * g + 3]);
                    *(LAS u32x2*)(lds + SC_P + (32 * tb2 + r32) * SC_TROW + (32 * sb + 8 * g + 4 * hh) * 2) = w; } }
        }
        __syncthreads();
        if (wid < 6) {
#pragma unroll
            for (int sb = 0; sb < 2; ++sb) { if (sb > tb) break;
#pragma unroll
                for (int s = 0; s < 2; ++s) { const s16x8 a = *(const LAS s16x8*)(lds + SC_P + (32 * tb + r32) * SC_TROW + 64 * sb + 32 * s + 16 * hh), bb = *(const LAS s16x8*)(lds + SC_VT + (32 * vb + r32) * SC_TROW + 64 * sb + 32 * s + 16 * hh);
                    acc = __builtin_amdgcn_mfma_f32_32x32x16_bf16(a, bb, acc, 0, 0, 0); } }
            if (vb == 2 && r32 == 0) {
#pragma unroll
                for (int r = 0; r < 16; ++r) ((LAS float*)(lds + SC_DEN))[32 * tb + (r & 3) + 8 * (r >> 2) + 4 * hh] = acc[r]; }
        }
        __syncthreads();
        if (wid < 4) {
#pragma unroll
            for (int r = 0; r < 16; ++r) { const int t = 32 * tb + (r & 3) + 8 * (r >> 2) + 4 * hh; const float dn = fmaxf(fabsf(((const LAS float*)(lds + SC_DEN))[t]), ga[256 + t]);
                *(LAS bf16*)(lds + SC_HS + t * 128 + (32 * vb + r32) * 2) = (bf16)(pg8::cvt_pk_bf16(acc[r] * __builtin_amdgcn_rcpf(dn), 0.f) & 0xffffu); }
        }
        if (c + 1 < SEQ / 64) { if (par == 0) SC_WRITE(b, 1); else SC_WRITE(a, 0); }
        __syncthreads();
        *(u32x4*)(HS + (tok0 + (tid >> 3)) * 1024 + h * 256 + vs * 64 + (tid & 7) * 8) = *(const LAS u32x4*)(lds + SC_HS + (tid >> 3) * 128 + (tid & 7) * 16);
      }
    }
#undef SC_LOAD
#undef SC_BL
#undef SC_SCALE8
#undef SC_WRITE
#undef SC_TR
}
#ifndef MK_ONE_LAUNCH
#define MK_ONE_LAUNCH 1
#endif
constexpr int NPH_L = 13, NPHASES = 2 + DEPTH * NPH_L;
struct Args { const void* in[25]; float* out; unsigned char* ws; int lo, hi; };

template <int SITE  >
__global__ void __launch_bounds__(NWAVES * 64, 2) fwd(Args args) {
    extern __shared__ __attribute__((aligned(16))) unsigned char lds_raw[];
    LAS unsigned char* lds = (LAS unsigned char*)lds_raw;
    const int G = gridDim.x, bx = blockIdx.x, NGW = G * NWAVES;
    const int wave_s = __builtin_amdgcn_readfirstlane((int)(threadIdx.x >> 6));
#define PH_REGS int tid = wave_s * 64 + pg8::lane_id(); asm volatile("" : "+v"(tid)); const int lane = tid & 63, wave = __builtin_amdgcn_readfirstlane(tid >> 6), gw = opq_s(bx) * NWAVES + wave; (void)lane; (void)gw;
    typedef const void* cvp_t; const __attribute__((address_space(4))) cvp_t* kargs = (const __attribute__((address_space(4))) cvp_t*)__builtin_amdgcn_kernarg_segment_ptr();
    gu32* ctl = (gu32*)((GAS unsigned char*)kargs[26] + WS_CTL);
    static_assert(sizeof(Args) == 27 * 8 + 8, "Args layout: 25 inputs, out, ws at 8-byte slots 0..26, then lo, hi");
    volatile LAS unsigned* MISC = (volatile LAS unsigned*)(lds + MISC_OFF);
    { PH_REGS for (int u = tid; u < (LDS_BYTES - LDSCTL_OFF) / 4; u += NWAVES * 64) ((LAS unsigned*)(lds + LDSCTL_OFF))[u] = 0u; }
    __syncthreads();
    XcdBarrier bar; bar.bar = (unsigned*)ctl + 4096; bar.x = 0; bar.st = nullptr;
    if (MK_ONE_LAUNCH) bar = xcd_barrier_post((unsigned*)ctl + 4096, MISC + 8, wave_s);
    const int lo = ((const __attribute__((address_space(4))) int*)kargs)[54], hi = ((const __attribute__((address_space(4))) int*)kargs)[55];
#define INP(p) (lo <= (p) && (p) < hi)
#define SEL(k) (SITE < 0 || SITE == (k))
#define SEAMG(p) do { if (MK_ONE_LAUNCH && (p) + 1 < hi) xcd_barrier(bar, wave_s); } while (0)
#define SEAM(p) do { if (MK_ONE_LAUNCH && (p) + 1 < hi) grp_barrier(bar, wave_s); } while (0)

#define PH_PTRS GAS unsigned char* ws = (GAS unsigned char*)KARG(26); bf16* W = (bf16*)(ws + WS_W); bf16* XB = (bf16*)(ws + WS_HN); float* RS = (float*)(ws + WS_RS); unsigned char* BIG = (unsigned char*)(ws + WS_BIG); \
    const int grp_ = opq_s(bx) & 7; unsigned char* BIGG = BIG + (size_t)grp_ * S_GRP; (void)BIGG; float* COS = (float*)(ws + WS_COS); float* SIN = (float*)(ws + WS_SIN); float* GATES = (float*)(ws + WS_GATES); bf16* KM = (bf16*)(ws + WS_KM); bf16* VMT = (bf16*)(ws + WS_VMT); GAS unsigned char* dob = (GAS unsigned char*)KARG(25); bf16* D0 = (bf16*)dob; bf16* YB = (bf16*)(dob + 64 * MiB); float* OUTF = (float*)dob;     \
    (void)W; (void)XB; (void)RS; (void)BIG; (void)COS; (void)SIN; (void)GATES; (void)KM; (void)VMT; (void)D0; (void)YB; (void)OUTF;
#define GROW(off_, pitch_) ((bf16*)(BIGG + (off_) - (size_t)grp_ * GTOK * (pitch_)))
#define GTOKB(off_) ((bf16*)(BIGG + (off_)) - (size_t)grp_ * GTOK)
#define RSB(i_) (RS + (size_t)((i_) & 3) * 4 * M)
#define KARG(k) ((const GAS void*)kargs[opq_s(k)])
#define INF(k) ((const float*)(const GAS float*)KARG(k))
    if constexpr (SEL(0)) if (INP(0)) { PH_REGS PH_PTRS const float* x_in = INF(0); const float* mem_in = INF(1); const int* pos_in = (const int*)(const GAS int*)KARG(2);
        LAS float* scr = (LAS float*)(lds + wave * 16384);
        int off = 0;
#define CVT_JOB(src_, K_, Nsrc_, Ndst_, kind_, dst_, gk_) do { const int nnb_ = (Ndst_) / 32, items_ = ((K_) / 64) * nnb_; \
        for (int it_ = (gw - off + 2 * NGW) % NGW; it_ < items_; it_ += NGW) { const int kb_ = it_ / nnb_, nb_ = it_ % nnb_; \
            cvt_item((src_), (K_), (Nsrc_), src_col((kind_), nb_ * 32), (dst_) + (size_t)(nb_ * 32) * (K_), scr, kb_, lane, (gk_)); } \
        off = (off + items_) % NGW; } while (0)
        for (int j = 0; j < 2; ++j) {
            bf16* wm = W + WE_MLA + j * WE_MLA_SZ;
            CVT_JOB(INF(3) + (size_t)j * D * MLA_IN, D, MLA_IN, MLA_INP, CK_MLA_IN, wm + WE_MLA_IN, INF(13) + (2 * j) * D);
            CVT_JOB(INF(5) + (size_t)j * QRANK * 1536, QRANK, 1536, 1536, CK_MLA_UQ, wm + WE_MLA_UQ, (const float*)nullptr);
            CVT_JOB(INF(7) + (size_t)j * KVRANK * 2048, KVRANK, 2048, 2048, CK_MLA_UKV, wm + WE_MLA_UKV, (const float*)nullptr);
            CVT_JOB(INF(8) + (size_t)j * D * D, D, D, D, CK_ID, wm + WE_MLA_O, (const float*)nullptr);
            bf16* wl = W + WE_L + j * WE_L_SZ;
            CVT_JOB(INF(9) + (size_t)j * D * MLSTM_IN, D, MLSTM_IN, 3584, CK_L_IN, wl + WE_L_IN, INF(13) + (2 * j + 1) * D);
            CVT_JOB(INF(12) + (size_t)j * D * D, D, D, D, CK_ID, wl + WE_L_O, (const float*)nullptr);
        }
        for (int l = 0; l < DEPTH; ++l) {
            bf16* wmm = W + WE_M + l * WE_M_SZ;
            CVT_JOB(INF(20) + (size_t)l * D * D, D, D, D, CK_ID, wmm + WE_M_Q, INF(15) + l * D);
            CVT_JOB(INF(21) + (size_t)l * D * 2048, D, 2048, 2048, CK_ID, wmm + WE_M_KV, (const float*)nullptr);
            CVT_JOB(INF(22) + (size_t)l * D * D, D, D, D, CK_ID, wmm + WE_M_O, (const float*)nullptr);
            bf16* wf = W + WE_F + l * WE_F_SZ;
            CVT_JOB(INF(23) + (size_t)l * D * 2 * DFF, D, 2 * DFF, 2 * DFF, CK_F_GU, wf + WE_F_GU, INF(18) + l * D);
            CVT_JOB(INF(24) + (size_t)l * DFF * D, DFF, D, D, CK_ID, wf + WE_F_D, (const float*)nullptr);
        }
#undef CVT_JOB
        for (int idx = bx * (NWAVES * 64) + tid; idx < M * 32; idx += G * NWAVES * 64) {
            const int tok = idx >> 5, i = idx & 31;
            double f = 1.0; for (int q = 0; q < i; ++q) f *= 0.7498942093324559;
            const double ang = (double)pos_in[tok] * f;
            const double kq = __builtin_rint(ang * 0.6366197723675814);
            const double r = (ang - kq * 1.5707963267948966) - kq * 6.123233995736766e-17;
            const double r2 = r * r;
            const double sn = r * (1.0 + r2 * (-1.0 / 6 + r2 * (1.0 / 120 + r2 * (-1.0 / 5040 + r2 * (1.0 / 362880 + r2 * (-1.0 / 39916800 + r2 * (1.0 / 6227020800.0)))))));
            const double cs = 1.0 + r2 * (-0.5 + r2 * (1.0 / 24 + r2 * (-1.0 / 720 + r2 * (1.0 / 40320 + r2 * (-1.0 / 3628800 + r2 * (1.0 / 479001600 + r2 * (-1.0 / 87178291200.0)))))));
            const int qd = (int)((long long)kq & 3);
            const double c = (qd == 0) ? cs : (qd == 1) ? -sn : (qd == 2) ? -cs : sn;
            const double s = (qd == 0) ? sn : (qd == 1) ? cs : (qd == 2) ? -sn : -cs;
            COS[idx] = (float)c; SIN[idx] = (float)s;
        }
        { const float* gkv = INF(16);
          for (int r = gw; r < MMEM; r += NGW) { f32x4 v[4]; load_row_f32(mem_in + (size_t)r * D, lane, v); const float rs = rsqrtf(row_ssq(v) * (1.f / D) + EPS);
            for (int l = 0; l < DEPTH; ++l) { f32x4 g[4], o[4]; load_row_f32(gkv + l * D, lane, g);
#pragma unroll
                for (int j = 0; j < 4; ++j) o[j] = v[j] * rs * g[j];
                bf16* dst = (bf16*)(BIG + (size_t)(r >> 9) * S_GRP + memn_slab_off(l)) + (size_t)(r & 511) * D;
                store_row_bf16(dst, lane, o); } } }
        for (int r0 = gw; r0 < M; r0 += 8 * NGW) { f32x4 v[8][4]; float ss[8];
#pragma unroll
            for (int k = 0; k < 8; ++k) load_row8_f32(x_in + (size_t)(r0 + k * NGW) * D, lane, v[k]);
#pragma unroll
            for (int k = 0; k < 8; ++k) { float a = 0.f;
#pragma unroll
                for (int j = 0; j < 4; ++j) a += (v[k][j][0] * v[k][j][0] + v[k][j][1] * v[k][j][1]) + (v[k][j][2] * v[k][j][2] + v[k][j][3] * v[k][j][3]);
                ss[k] = a; }
#pragma unroll
            for (int k = 0; k < 8; ++k) ss[k] = wave_sum(ss[k]);
#pragma unroll
            for (int k = 0; k < 8; ++k) { store_row8_bf16(XB + (size_t)(r0 + k * NGW) * D, lane, v[k]); if (lane < 4) RS[(size_t)lane * M + r0 + k * NGW] = lane == 0 ? ss[k] : 0.f; } }
        SEAMG(0);
    }
    if constexpr (SEL(1)) if (INP(1)) { PH_PTRS
        const int bxo = opq_s(bx); const int x = bxo & 7, j = bxo >> 3, l = 1 + 2 * (j >> 4), b = 2 * x + ((j >> 3) & 1), q = j & 3; const bool isk = ((j >> 2) & 1) == 0;
        const bf16* MEMN = (const bf16*)(BIG + (size_t)x * S_GRP + memn_slab_off(l)) - (size_t)x * 512 * D;     const bf16* wkv = W + WE_M + l * WE_M_SZ + WE_M_KV;
        if (G == 256) {
            pg8::Gemm g{isk ? MEMN : wkv + (size_t)D * D, isk ? wkv : MEMN, isk ? MMEM : D, isk ? D : MMEM, D}; pg8::OneOrder S; S.u0.pm = isk ? b : q; S.u0.pn = isk ? q : b; S.u0.w = 0;
            pg8::EpiPlain E{isk ? KM + (size_t)l * MMEM * D : VMT + (size_t)l * D * VMT_LD, isk ? (size_t)D : (size_t)VMT_LD, 1.f, nullptr};
            pg8::gemm_phase<pg8::EpiPlain, pg8::OneOrder, true, true>(lds, g, S, E, wave_s);
        }
        SEAM(1);
    }

#define UNPK8(w_, lo_, hi_) do { lo_ = (f32x4){bflo((w_).x), bfhi((w_).x), bflo((w_).y), bfhi((w_).y)}; hi_ = (f32x4){bflo((w_).z), bfhi((w_).z), bflo((w_).w), bfhi((w_).w)}; } while (0)
#define SSQ8(a_, b_) (((a_[0] * a_[0] + a_[1] * a_[1]) + (a_[2] * a_[2] + a_[3] * a_[3])) + ((b_[0] * b_[0] + b_[1] * b_[1]) + (b_[2] * b_[2] + b_[3] * b_[3])))
#define ROW_PASS8(rb_, Y_, gpost_, want_rs_, gates_, gb_, outf_, rso_) do { float* rso__ = (rso_); \
        const bf16* Y__ = (Y_); const float* gb__ = (gb_); float* outf__ = (outf_); const bool wrs__ = (want_rs_), gts__ = (gates_); \
        const LAS float* wgl = (const LAS float*)lds; \
        f32x4 gp__[4]; load_row8_f32((gpost_), lane, gp__); \
        u32x4 yw_[8][2], xw_[8][2]; float sy_[8], sx_[8]; \
          \
        _Pragma("unroll") for (int k_ = 0; k_ < 8; ++k_) { const size_t ro_ = (size_t)((rb_) + wave + 8 * k_) * D + 8 * lane; \
            _Pragma("unroll") for (int jj_ = 0; jj_ < 2; ++jj_) { \
                if (Y__) { const bf16* yp_ = Y__ + ro_ + 512 * jj_; asm volatile("global_load_dwordx4 %0, %1, off sc1" : "=v"(yw_[k_][jj_]) : "v"(yp_) : "memory"); xw_[k_][jj_] = *(const u32x4*)(XB + ro_ + 512 * jj_); } \
                else { yw_[k_][jj_] = (u32x4){0u, 0u, 0u, 0u}; const bf16* xp_ = XB + ro_ + 512 * jj_; asm volatile("global_load_dwordx4 %0, %1, off sc1" : "=v"(xw_[k_][jj_]) : "v"(xp_) : "memory"); } } }     \
        asm volatile("s_waitcnt vmcnt(0)" : "+v"(yw_[0][0]), "+v"(yw_[0][1]), "+v"(yw_[1][0]), "+v"(yw_[1][1]), "+v"(yw_[2][0]), "+v"(yw_[2][1]), "+v"(yw_[3][0]), "+v"(yw_[3][1]), \
                                             "+v"(yw_[4][0]), "+v"(yw_[4][1]), "+v"(yw_[5][0]), "+v"(yw_[5][1]), "+v"(yw_[6][0]), "+v"(yw_[6][1]), "+v"(yw_[7][0]), "+v"(yw_[7][1]) :: "memory"); \
        asm volatile("" : "+v"(xw_[0][0]), "+v"(xw_[0][1]), "+v"(xw_[1][0]), "+v"(xw_[1][1]), "+v"(xw_[2][0]), "+v"(xw_[2][1]), "+v"(xw_[3][0]), "+v"(xw_[3][1]), \
                         "+v"(xw_[4][0]), "+v"(xw_[4][1]), "+v"(xw_[5][0]), "+v"(xw_[5][1]), "+v"(xw_[6][0]), "+v"(xw_[6][1]), "+v"(xw_[7][0]), "+v"(xw_[7][1]) :: "memory"); \
        _Pragma("unroll") for (int k_ = 0; k_ < 8; ++k_) { float s_ = 0.f; \
            _Pragma("unroll") for (int jj_ = 0; jj_ < 2; ++jj_) { f32x4 a_, b_; UNPK8(yw_[k_][jj_], a_, b_); s_ += SSQ8(a_, b_); } sy_[k_] = s_; } \
        _Pragma("unroll") for (int k_ = 0; k_ < 8; ++k_) sy_[k_] = wave_sum(sy_[k_]); \
        _Pragma("unroll") for (int k_ = 0; k_ < 8; ++k_) { const int r_ = (rb_) + wave + 8 * k_; const float rs_ = rsqrtf(sy_[k_] * (1.f / D) + EPS); float s_ = 0.f; f32x4 x_[4]; \
            asm volatile("" : "+v"(yw_[k_][0]), "+v"(yw_[k_][1]), "+v"(xw_[k_][0]), "+v"(xw_[k_][1]));     \
            _Pragma("unroll") for (int jj_ = 0; jj_ < 2; ++jj_) { f32x4 ya_, yb_, xa_, xb_; UNPK8(yw_[k_][jj_], ya_, yb_); UNPK8(xw_[k_][jj_], xa_, xb_); \
                x_[2 * jj_] = xa_ + ya_ * rs_ * gp__[2 * jj_]; x_[2 * jj_ + 1] = xb_ + yb_ * rs_ * gp__[2 * jj_ + 1]; s_ += SSQ8(x_[2 * jj_], x_[2 * jj_ + 1]); } \
            if (outf__) { _Pragma("unroll") for (int j_ = 0; j_ < 4; ++j_) *(f32x4*)(outf__ + (size_t)r_ * D + 8 * lane + 512 * (j_ >> 1) + 4 * (j_ & 1)) = x_[j_]; } \
            else if (Y__) store_row8_bf16(XB + (size_t)r_ * D, lane, x_); \
            sx_[k_] = s_; \
            if (gts__) { float ga_[8]; \
                _Pragma("unroll") for (int g_ = 0; g_ < 8; ++g_) { float a_ = 0.f; \
                    _Pragma("unroll") for (int j_ = 0; j_ < 4; ++j_) { const f32x4 w_ = *(const LAS f32x4*)(wgl + g_ * D + 8 * lane + 512 * (j_ >> 1) + 4 * (j_ & 1)); a_ += (x_[j_][0] * w_[0] + x_[j_][1] * w_[1]) + (x_[j_][2] * w_[2] + x_[j_][3] * w_[3]); } \
                    ga_[g_] = a_; } \
                const float st_ = wave_sum(s_); \
                _Pragma("unroll") for (int g_ = 0; g_ < 8; ++g_) ga_[g_] = wave_sum(ga_[g_]); \
                const float r2_ = rsqrtf(st_ * (1.f / D) + EPS); float out_ = 0.f; \
                _Pragma("unroll") for (int g_ = 0; g_ < 8; ++g_) if (lane == g_) out_ = ga_[g_] * r2_ + gb__[g_]; \
                if (Y__ && lane < 4) rso__[(size_t)lane * M + r_] = lane == 0 ? st_ : 0.f; if (lane < 8) GATES[(size_t)r_ * 8 + lane] = out_; } } \
        if (wrs__ && !gts__) { \
            _Pragma("unroll") for (int k_ = 0; k_ < 8; ++k_) sx_[k_] = wave_sum(sx_[k_]); \
            _Pragma("unroll") for (int k_ = 0; k_ < 8; ++k_) if (lane < 4) rso__[(size_t)lane * M + (rb_) + wave + 8 * k_] = lane == 0 ? sx_[k_] : 0.f; } } while (0)
#define FUSED_TAIL(sidx_, S_, Y_, gpost_, gpre_, gw_src_, gb_, outf_) do { PH_REGS \
        gu32* tk_ = (gu32*)((GAS unsigned char*)KARG(26) + WS_CTL) + 32768 + (size_t)(sidx_) * (128 * 16); pg8::Unit u_ = {0, 0, 0};     \
        if (tid == 0) { if (MISC[10] == 0u) __builtin_amdgcn_fence(__ATOMIC_RELEASE, "agent");     \
            asm volatile("s_waitcnt vmcnt(0)" ::: "memory"); \
            for (int i_ = 0; (S_).next(i_, u_); ++i_) (void)__hip_atomic_fetch_add(tk_ + u_.pm * 16, 1u, __ATOMIC_RELAXED, __HIP_MEMORY_SCOPE_AGENT); } \
        const float* gws__ = (gw_src_); const float* gpre__ = (gpre_); \
        if (gws__) { LAS float* wst_ = (LAS float*)lds;     \
            for (int i_ = tid; i_ < 8 * D; i_ += NWAVES * 64) { const int k_ = i_ >> 3, g_ = i_ & 7; wst_[g_ * D + k_] = gws__[(size_t)k_ * MLSTM_IN + 3072 + g_] * gpre__[k_]; } } \
        for (int i_ = 0; (S_).next(i_, u_); ++i_) { \
            if (tid == 0) { unsigned sp_ = 0; while (__hip_atomic_load(tk_ + u_.pm * 16, __ATOMIC_RELAXED, __HIP_MEMORY_SCOPE_AGENT) < 4u && ++sp_ < (1u << 22)) __builtin_amdgcn_s_sleep(1); \
                if (MISC[10] == 0u) { __builtin_amdgcn_fence(__ATOMIC_ACQUIRE, "agent"); asm volatile("s_waitcnt vmcnt(0)" ::: "memory"); } }     \
            __syncthreads(); \
            const int rb__ = u_.pm * 256 + u_.pn * 64; \
            ROW_PASS8(rb__, Y_, gpost_, gpre__ != nullptr, gws__ != nullptr, gb_, outf_, RSB((sidx_) + 1)); } \
        if (gws__) __syncthreads(); } while (0)

#define LN_EPI(sidx_, gpost_) pg8::EpiLN E{XB, (gpost_), RSB((sidx_) + 1), (float*)(ws + WS_EX), (unsigned*)(ws + WS_CTL) + 32768 + (size_t)(sidx_) * (128 * 16), (LAS float*)(lds + RING_BYTES + 1024), MISC[10], (float*)nullptr}
    for (int l = 0; l < DEPTH; ++l) {
        const int base = 2 + l * NPH_L, j = l >> 1;
        if ((l & 1) == 0) {
#define MLA_PTRS PH_PTRS const bf16* wm = W + WE_MLA + j * WE_MLA_SZ; bf16* PROJ = GROW(B_QN, MLA_INP * 2); bf16* QN = GROW(B_QN, 2048); bf16* QR = GROW(B_QR, 1024); bf16* VT = GTOKB(B_VT); \
            bf16* CQN = GROW(B_CQN, QRANK * 2); bf16* CKVN = GROW(B_CKVN, KVRANK * 2); bf16* KR = GROW(B_KR, 128); bf16* KN = D0; \
            (void)wm; (void)PROJ; (void)QN; (void)QR; (void)VT; (void)CQN; (void)CKVN; (void)KR; (void)KN;
            if constexpr (SEL(2)) if (INP(base + 0)) { MLA_PTRS
                {
                {
                const bf16* MEMN = (const bf16*)(BIGG + memn_slab_off(l)) - (size_t)grp_ * 512 * D;     const bf16* wkv = W + WE_M + l * WE_M_SZ + WE_M_KV;
                pg8::Gemm g{XB, wm + WE_MLA_IN, M, MLA_INP, D}; pg8::TriOrder S; S.s0.init(M, MLA_INP, G, opq_s(bx)); const bf16* wv = wkv + (size_t)D * D;
                S.dA1 = (const char*)MEMN - (const char*)XB; S.dB1 = (const char*)wkv - (const char*)(wm + WE_MLA_IN); S.dA2 = (const char*)wv - (const char*)XB; S.dB2 = (const char*)MEMN - (const char*)(wm + WE_MLA_IN);
                pg8::EpiTri E{PROJ, (size_t)MLA_INP, RSB(3 * l), (KM + (size_t)l * MMEM * D) - PROJ, (long)D - (long)MLA_INP, (VMT + (size_t)l * D * VMT_LD) - PROJ, (long)VMT_LD - (long)MLA_INP};
                pg8::gemm_phase<pg8::EpiTri, pg8::TriOrder, true, true>(lds, g, S, E, wave_s);
                }
                }
                SEAM(base + 0);
            }
            if constexpr (SEL(3)) if (INP(base + 1)) { PH_REGS MLA_PTRS
                const float* gq = INF(4) + j * QRANK; const float* gkv = INF(6) + j * KVRANK;
                const int bxo = opq_s(bx), vcu = (G % 8 == 0) ? (bxo % 8) * (G / 8) + bxo / 8 : bxo; const int rpw = M / NGW;
                float gq6[6];
#pragma unroll
                for (int jj = 0; jj < 3; ++jj) { gq6[2 * jj] = gq[2 * lane + 128 * jj]; gq6[2 * jj + 1] = gq[2 * lane + 128 * jj + 1]; }
                const f32x4 g4 = *(const f32x4*)(gkv + 4 * lane);
                for (int r0 = (vcu * NWAVES + wave) * rpw; r0 < (vcu * NWAVES + wave + 1) * rpw; r0 += 8) {
                    unsigned cw[8][3]; u32x2 wk[8]; bf16 krw[8]; float cs[8], sn[8];
#pragma unroll
                    for (int k = 0; k < 8; ++k) { const bf16* p = PROJ + (size_t)(r0 + k) * MLA_INP;
#pragma unroll
                        for (int jj = 0; jj < 3; ++jj) cw[k][jj] = *(const unsigned*)(p + 2 * lane + 128 * jj);
                        wk[k] = *(const u32x2*)(p + QRANK + 4 * lane); krw[k] = p[QRANK + KVRANK + lane];
                        cs[k] = COS[(size_t)(r0 + k) * 32 + (lane & 31)]; sn[k] = SIN[(size_t)(r0 + k) * 32 + (lane & 31)]; }
#pragma unroll
                    for (int k = 0; k < 8; ++k) { const int r = r0 + k;
                        float cq[6]; float s1 = 0.f;
#pragma unroll
                        for (int jj = 0; jj < 3; ++jj) { cq[2 * jj] = bflo(cw[k][jj]); cq[2 * jj + 1] = bfhi(cw[k][jj]); s1 += cq[2 * jj] * cq[2 * jj] + cq[2 * jj + 1] * cq[2 * jj + 1]; }
                        const f32x4 ck = (f32x4){bflo(wk[k].x), bfhi(wk[k].x), bflo(wk[k].y), bfhi(wk[k].y)};
                        float s2 = (ck[0] * ck[0] + ck[1] * ck[1]) + (ck[2] * ck[2] + ck[3] * ck[3]);
                        const float kr = bf2f(krw[k]);
                        s1 = wave_sum(s1); s2 = wave_sum(s2);
                        const float r1 = rsqrtf(s1 * (1.f / QRANK) + EPS), r2 = rsqrtf(s2 * (1.f / KVRANK) + EPS);
#pragma unroll
                        for (int jj = 0; jj < 3; ++jj) *(unsigned*)(CQN + (size_t)r * QRANK + 2 * lane + 128 * jj) = pg8::cvt_pk_bf16(cq[2 * jj] * r1 * gq6[2 * jj], cq[2 * jj + 1] * r1 * gq6[2 * jj + 1]);
                        { u32x2 w; w.x = pg8::cvt_pk_bf16(ck[0] * r2 * g4[0], ck[1] * r2 * g4[1]); w.y = pg8::cvt_pk_bf16(ck[2] * r2 * g4[2], ck[3] * r2 * g4[3]);
                          *(u32x2*)(CKVN + (size_t)r * KVRANK + 4 * lane) = w; }
                        { float other; { auto rr = __builtin_amdgcn_permlane32_swap(__float_as_uint(kr), __float_as_uint(kr), false, false); other = (lane < 32) ? __uint_as_float(rr[1]) : __uint_as_float(rr[0]); }
                          const float o = (lane < 32) ? (kr * cs[k] - other * sn[k]) : (kr * cs[k] + other * sn[k]);
                          KR[(size_t)r * 64 + lane] = (bf16)(pg8::cvt_pk_bf16(o, 0.f) & 0xffffu); }
                    }
                }
                SEAM(base + 1);
            }
            if constexpr (SEL(4)) if (INP(base + 2)) { MLA_PTRS
                {
                { pg8::Gemm g{CQN, wm + WE_MLA_UQ, M, 1536, QRANK}; pg8::StaticOrder S; S.init(M, 1536, G, opq_s(bx)); pg8::EpiSplit E{QN, (size_t)1024, 4, QR, (size_t)512, MLA_QS};
                  pg8::gemm_phase<pg8::EpiSplit, pg8::StaticOrder, true, true>(lds, g, S, E, wave_s); }
                { pg8::Gemm g{CKVN, wm + WE_MLA_UKV, M, D, KVRANK}; pg8::StaticOrder S; S.init(M, D, G, opq_s(bx)); pg8::EpiPlain E{KN, (size_t)D, 1.f, nullptr};
                  pg8::gemm_phase<pg8::EpiPlain, pg8::StaticOrder, true, true>(lds, g, S, E, wave_s); }
                { pg8::Gemm g{wm + WE_MLA_UKV + (size_t)D * KVRANK, CKVN, D, M, KVRANK}; pg8::StaticOrder S; S.init(D, M, G, opq_s(bx)); pg8::EpiPlain E{VT, (size_t)VT_LD, 1.f, nullptr};
                  pg8::gemm_phase<pg8::EpiPlain, pg8::StaticOrder, true, true>(lds, g, S, E, wave_s); }
                }
                SEAM(base + 2);
            }
            if constexpr (SEL(5)) if (INP(base + 3)) { PH_REGS MLA_PTRS
                const int bxo = opq_s(bx), vcu = (G % 8 == 0) ? (bxo % 8) * (G / 8) + bxo / 8 : bxo;
                for (int p = vcu; p < NB * MLA_H * 4; p += G) { const int v_ = p % G, rnd = p / G, x = v_ & 3, h = (v_ >> 2) & 7, b = (G == 256) ? 2 * (v_ >> 5) + rnd : (p >> 5);
                    mla_attn_unit(b, h, 7 - x, QN, QR, KN, KR, VT, COS, SIN, QN, lds, tid);
                    mla_attn_unit(b, h, x, QN, QR, KN, KR, VT, COS, SIN, QN, lds, tid); }
                SEAM(base + 3);
            }
            if constexpr (SEL(6)) if (INP(base + 4)) { MLA_PTRS
                pg8::Gemm g{QN, wm + WE_MLA_O, M, D, D}; pg8::StaticOrder S; S.init(M, D, G, opq_s(bx)); LN_EPI(l * 3 + 0, INF(14) + l * D);
                pg8::gemm_phase<pg8::EpiLN, pg8::StaticOrder, true, true>(lds, g, S, E, wave_s);
                SEAM(base + 5);
            }
        } else {
#define L_PTRS PH_PTRS const bf16* wl = W + WE_L + j * WE_L_SZ; bf16* QK = GROW(B_QK, 2048); bf16* OG = GROW(B_OG, 2048); bf16* KVT = GTOKB(B_KVT); bf16* HS = D0; bf16* GA = GROW(B_QK, 2048); \
            (void)wl; (void)QK; (void)OG; (void)KVT; (void)HS; (void)GA;
            if constexpr (SEL(7)) if (INP(base + 0)) { L_PTRS
                {
                {
                { pg8::Gemm g{XB, wl + WE_L_IN, M, 2048, D}; pg8::StaticOrder S; S.init(M, 2048, G, opq_s(bx)); pg8::EpiQKO E{QK, OG, LQ_S, RSB(3 * l)};
                  pg8::gemm_phase<pg8::EpiQKO, pg8::StaticOrder, true, true>(lds, g, S, E, wave_s); }
                { pg8::Gemm g{wl + WE_L_IN + (size_t)2560 * D, XB, 1024, M, D}; pg8::StaticOrder S; S.init(1024, M, G, opq_s(bx)); pg8::EpiPlainT<2> E{KVT, (size_t)KVT_LD, 1.f, RSB(3 * l)};
                  pg8::gemm_phase<pg8::EpiPlainT<2>, pg8::StaticOrder, true, true>(lds, g, S, E, wave_s); }
                }
                }
                SEAM(base + 0);
            }
            if constexpr (SEL(8)) if (INP(base + 1)) { PH_REGS L_PTRS
                { const int bxo = opq_s(bx), vcu = (G % 8 == 0) ? (bxo % 8) * (G / 8) + bxo / 8 : bxo;
                  for (int u = vcu; u < NB * LH * 4; u += G) mlstm_scan_unit(u, QK, KVT, GATES, HS, lds, tid); }
                SEAM(base + 1);
            }
            if constexpr (SEL(9)) if (INP(base + 2)) { PH_REGS L_PTRS
                const float* hn = INF(11) + j * LH * LDV;
                const int bxo = opq_s(bx), vcu = (G % 8 == 0) ? (bxo % 8) * (G / 8) + bxo / 8 : bxo; const int rpw = M / NGW;
                f32x4 gh[4]; load_row8_f32(hn, lane, gh);
                for (int r0 = (vcu * NWAVES + wave) * rpw; r0 < (vcu * NWAVES + wave + 1) * rpw; r0 += 8) {
                    u32x4 hw[8][2], ow[8][2];
#pragma unroll
                    for (int k = 0; k < 8; ++k)
#pragma unroll
                        for (int jj = 0; jj < 2; ++jj) { hw[k][jj] = *(const u32x4*)(HS + (size_t)(r0 + k) * D + 8 * lane + 512 * jj); ow[k][jj] = *(const u32x4*)(OG + (size_t)(r0 + k) * D + 8 * lane + 512 * jj); }
#pragma unroll
                    for (int k = 0; k < 8; ++k)
#pragma unroll
                        for (int jj = 0; jj < 2; ++jj) { const u32x4 h = hw[k][jj], o = ow[k][jj];
                            const f32x4 h0 = (f32x4){bflo(h.x), bfhi(h.x), bflo(h.y), bfhi(h.y)}, h1 = (f32x4){bflo(h.z), bfhi(h.z), bflo(h.w), bfhi(h.w)};
                            const f32x4 o0 = (f32x4){bflo(o.x), bfhi(o.x), bflo(o.y), bfhi(o.y)}, o1 = (f32x4){bflo(o.z), bfhi(o.z), bflo(o.w), bfhi(o.w)};
                            float ss = ((h0[0] * h0[0] + h0[1] * h0[1]) + (h0[2] * h0[2] + h0[3] * h0[3])) + ((h1[0] * h1[0] + h1[1] * h1[1]) + (h1[2] * h1[2] + h1[3] * h1[3]));
                            ss = half_sum(ss);
                            const float rs = rsqrtf(ss * (1.f / LDV) + EPS);
                            const f32x4 a0 = h0 * rs * gh[2 * jj] * o0, a1 = h1 * rs * gh[2 * jj + 1] * o1;
                            u32x4 w; w.x = pg8::cvt_pk_bf16(a0[0], a0[1]); w.y = pg8::cvt_pk_bf16(a0[2], a0[3]); w.z = pg8::cvt_pk_bf16(a1[0], a1[1]); w.w = pg8::cvt_pk_bf16(a1[2], a1[3]);
                            *(u32x4*)(GA + (size_t)(r0 + k) * D + 8 * lane + 512 * jj) = w; }
                }
                SEAM(base + 2);
            }
            if constexpr (SEL(10)) if (INP(base + 4)) { L_PTRS
                pg8::Gemm g{GA, wl + WE_L_O, M, D, D}; pg8::StaticOrder S; S.init(M, D, G, opq_s(bx)); LN_EPI(l * 3 + 0, INF(14) + l * D);
                pg8::gemm_phase<pg8::EpiLN, pg8::StaticOrder, true, true>(lds, g, S, E, wave_s);
                SEAM(base + 5);
            }
        }
        {
#define MEM_PTRS PH_PTRS const bf16* wmm = W + WE_M + l * WE_M_SZ; bf16* QM = GROW(B_QM, 2048); (void)wmm; (void)QM;
            if constexpr (SEL(12)) if (INP(base + 6)) { MEM_PTRS
                {
                pg8::Gemm g{XB, wmm + WE_M_Q, M, D, D}; pg8::StaticOrder S; S.init(M, D, G, opq_s(bx)); pg8::EpiPlainT<1> E{QM, (size_t)D, MEM_QS, RSB(3 * l + 1)};
                pg8::gemm_phase<pg8::EpiPlainT<1>, pg8::StaticOrder, true, true>(lds, g, S, E, wave_s);
                }
                SEAM(base + 6);
            }
            if constexpr (SEL(13)) if (INP(base + 7)) { PH_REGS MEM_PTRS
                const bf16* km = KM + (size_t)l * MMEM * D; const bf16* vmt = VMT + (size_t)l * D * VMT_LD;
                const int bxo = opq_s(bx), vcu = (G % 8 == 0) ? (bxo % 8) * (G / 8) + bxo / 8 : bxo;
                for (int u = vcu; u < (M / 256) * 4; u += G) { const int v_ = u % G, rnd = u / G, pmi = v_ & 7, h = (v_ >> 3) & 3, b = (G == 256) ? 2 * (v_ >> 5) + rnd : (u >> 5);
                    mem_attn_unit(b * 8 + pmi, h, QM, km, vmt, QM, lds, tid); }
                SEAM(base + 7);
            }
            if constexpr (SEL(14)) if (INP(base + 8)) { MEM_PTRS
                pg8::Gemm g{QM, wmm + WE_M_O, M, D, D}; pg8::StaticOrder S; S.init(M, D, G, opq_s(bx)); LN_EPI(l * 3 + 1, INF(17) + l * D);
                pg8::gemm_phase<pg8::EpiLN, pg8::StaticOrder, true, true>(lds, g, S, E, wave_s);
                SEAM(base + 9);
            }
        }
        {
#define FFN_PTRS PH_PTRS const bf16* wf = W + WE_F + l * WE_F_SZ; bf16* HID = GROW(B_HID, DFF * 2); (void)wf; (void)HID;
            if constexpr (SEL(16)) if (INP(base + 10)) { FFN_PTRS
                {
                pg8::Gemm g{XB, wf + WE_F_GU, M, 2 * DFF, D}; pg8::StaticOrder S; S.init(M, 2 * DFF, G, opq_s(bx)); pg8::EpiSwiGLU E{HID, (size_t)DFF, RSB(3 * l + 2)};
                pg8::gemm_phase<pg8::EpiSwiGLU, pg8::StaticOrder, true, true>(lds, g, S, E, wave_s);
                }
                if (l + 1 < DEPTH) SEAM(base + 10); else SEAMG(base + 10);
            }
            if constexpr (SEL(17)) if (INP(base + 11)) { FFN_PTRS
                bf16* YF = (l + 1 < DEPTH) ? YB : (bf16*)KM;
                pg8::Gemm g{HID, wf + WE_F_D, M, D, DFF}; pg8::StaticOrder S; S.init(M, D, G, opq_s(bx));
                {
                    pg8::EpiLN E{XB, INF(19) + l * D, RSB((l * 3 + 2) + 1), (float*)(ws + WS_EX), (unsigned*)(ws + WS_CTL) + 32768 + (size_t)(l * 3 + 2) * (128 * 16), (LAS float*)(lds + RING_BYTES + 1024), MISC[10], (l + 1 == DEPTH) ? OUTF : (float*)nullptr};
                    pg8::gemm_phase<pg8::EpiLN, pg8::StaticOrder, true, true>(lds, g, S, E, wave_s);
                    if ((l + 1 < DEPTH) && ((l + 1) & 1)) FUSED_TAIL(l * 3 + 2 + 12, S, (const bf16*)nullptr, INF(19) + l * D, INF(13) + (l + 1) * D, INF(9) + (size_t)j * D * MLSTM_IN, INF(10) + j * 8, (float*)nullptr);
                }
                SEAM(base + 12);
            }
        }
    }
}

template <int S> static void launch_site(const Args& a, hipStream_t stream) {
    static bool attr = false;
    if (!attr) { attr = true; if (hipFuncSetAttribute((const void*)fwd<S>, hipFuncAttributeMaxDynamicSharedMemorySize, LDS_BYTES) != hipSuccess) fprintf(stderr, "kernel_launch: hipFuncSetAttribute failed (site %d)\n", S); }
    hipLaunchKernelGGL(fwd<S>, dim3(256), dim3(NWAVES * 64), LDS_BYTES, stream, a);
}
extern "C" void kernel_launch(void* const* d_in, const int* in_sizes, int n_in, void* d_out, int out_size, void* d_ws, size_t ws_size, hipStream_t stream) {
    if (n_in != 25 || out_size != M * D || ws_size < WS_END) { fprintf(stderr, "kernel_launch: unexpected shapes (n_in %d out %d ws %zu)\n", n_in, out_size, ws_size); return; }
    (void)hipMemsetAsync((char*)d_ws + WS_CTL, 0, CTL_ZERO_BYTES, stream);
    Args a{};
    for (int i = 0; i < 25; ++i) a.in[i] = d_in[i];
    a.out = (float*)d_out; a.ws = (unsigned char*)d_ws;
#if MK_ONE_LAUNCH
    a.lo = 0; a.hi = NPHASES;
    launch_site<-1>(a, stream);
#else
    for (int p = 0; p < NPHASES; ++p) {
        a.lo = p; a.hi = p + 1;
        if (p == 0) { launch_site<0>(a, stream); continue; }
        if (p == 1) { launch_site<1>(a, stream); continue; }
        const int k = (p - 2) % NPH_L, l = (p - 2) / NPH_L; const bool mla = (l & 1) == 0;
        switch (k) {
        case 0: if (mla) launch_site<2>(a, stream); else launch_site<7>(a, stream); break;
        case 1: if (mla) launch_site<3>(a, stream); else launch_site<8>(a, stream); break;
        case 2: if (mla) launch_site<4>(a, stream); else launch_site<9>(a, stream); break;
        case 3: if (mla) launch_site<5>(a, stream); break;
        case 4: if (mla) launch_site<6>(a, stream); else launch_site<10>(a, stream); break;
        case 5: launch_site<11>(a, stream); break;
        case 6: launch_site<12>(a, stream); break;
        case 7: launch_site<13>(a, stream); break;
        case 8: launch_site<14>(a, stream); break;
        case 9: launch_site<15>(a, stream); break;
        case 10: launch_site<16>(a, stream); break;
        case 11: launch_site<17>(a, stream); break;
        default: launch_site<18>(a, stream); break;
        }
    }
#endif
}
```

```cpp
#include <hip/hip_runtime.h>
#include <cstdio>
#include <cstdint>
namespace pg8 {
#define PG8_LAS __attribute__((address_space(3)))
typedef unsigned short bf16_t;
typedef short bf16x8 __attribute__((ext_vector_type(8)));
typedef float f32x4 __attribute__((ext_vector_type(4)));
typedef unsigned u32x4 __attribute__((ext_vector_type(4)));
constexpr int BM = 256, BK = 64, HALF = 128, HTB = HALF * BK * 2  , STAGE_BYTES = 8 * HTB, NXCD = 8, WGM = 8;

__host__ __device__ __forceinline__ int lds_byte(int r, int c) { const int st = (r >> 4) * 2 + (c >> 5), rr = r & 15, cc = c & 31, ob = rr * 64 + cc * 2; return st * 1024 + (ob ^ (((ob >> 9) & 1) << 5)); }
__host__ __device__ __forceinline__ void stage_rc(int b, int& R, int& C) { const int st = b / 1024, sb = b % 1024, swz = sb ^ (((sb >> 9) & 1) << 5); R = (st >> 1) * 16 + swz / 64; C = (st & 1) * 32 + (swz % 64) / 2; }
__host__ __device__ __forceinline__ int perm32(int rho) { const int n = rho >> 4, i = rho & 15; return 8 * (i >> 2) + 4 * n + (i & 3); }

__device__ __forceinline__ int lane_id() { int l; asm volatile("v_mbcnt_lo_u32_b32 %0, -1, 0\n\tv_mbcnt_hi_u32_b32 %0, -1, %0" : "=v"(l)); return l; }
struct Unit { int pm, pn, w; };
struct Gemm { const bf16_t* A; const bf16_t* Bt; int M, N, K; };

struct StaticOrder {
    int nM, nN, nwg, G, c;
    __host__ __device__ __forceinline__ void init(int M, int N, int G_, int c_) { nM = M / BM; nN = N / BM; nwg = nM * nN; G = G_; c = c_; }
    __host__ __device__ __forceinline__ bool next(int i, Unit& u) const {
        const long L = (long)i * G + c; if (L >= nwg) return false;
        int wgid = (int)L; { const int q = nwg / NXCD, r = nwg % NXCD, xcd = wgid % NXCD, off = wgid / NXCD; wgid = (xcd < r ? xcd * (q + 1) : r * (q + 1) + (xcd - r) * q) + off; }
        const int nig = WGM * nN, gid = wgid / nig, fm = gid * WGM, gsz = (nM - fm) < WGM ? (nM - fm) : WGM;
        u.pm = fm + ((wgid % nig) % gsz); u.pn = (wgid % nig) / gsz; u.w = 0; return true;
    }
    __device__ __forceinline__ void a_ready(const Unit&) const {}
    __device__ __forceinline__ void done(const Unit&) const {}
    __device__ __forceinline__ const char* a_panel(const Unit& u, const Gemm& g, size_t tstep) const { return (const char*)g.A + (size_t)u.pm * tstep; }
    __device__ __forceinline__ const char* b_panel(const Unit& u, const Gemm& g, size_t tstep) const { return (const char*)g.Bt + (size_t)u.pn * tstep; }
};
struct OneOrder {
    Unit u0;
    __device__ __forceinline__ bool next(int i, Unit& u) const { u.pm = u0.pm; u.pn = u0.pn; u.w = 0; return i == 0; }
    __device__ __forceinline__ void a_ready(const Unit&) const {}
    __device__ __forceinline__ void done(const Unit&) const {}
    __device__ __forceinline__ const char* a_panel(const Unit& u, const Gemm& g, size_t tstep) const { return (const char*)g.A + (size_t)u.pm * tstep; }
    __device__ __forceinline__ const char* b_panel(const Unit& u, const Gemm& g, size_t tstep) const { return (const char*)g.Bt + (size_t)u.pn * tstep; }
};
struct DualOrder {
    StaticOrder s0, s1; const bf16_t* A1; const bf16_t* B1;
    __device__ __forceinline__ bool next(int i, Unit& u) const {
        const int r0 = s0.nwg / s0.G;
        if (i < r0) { const bool ok = s0.next(i, u); u.w = 0; return ok; }
        const bool ok = s1.next(i - r0, u); u.w = 1; return ok; }
    __device__ __forceinline__ void a_ready(const Unit&) const {}
    __device__ __forceinline__ void done(const Unit&) const {}
    __device__ __forceinline__ const char* a_panel(const Unit& u, const Gemm& g, size_t tstep) const { return (const char*)(u.w ? A1 : g.A) + (size_t)u.pm * tstep; }
    __device__ __forceinline__ const char* b_panel(const Unit& u, const Gemm& g, size_t tstep) const { return (const char*)(u.w ? B1 : g.Bt) + (size_t)u.pn * tstep; }
};
struct TriOrder {
    StaticOrder s0; long dA1, dB1, dA2, dB2;
    __device__ __forceinline__ bool next(int i, Unit& u) const {
        const int L = i * s0.G + s0.c; const bool in0 = L < s0.nwg;
        Unit a = {0, 0, 0}; if (in0) s0.next(i, a);
        const int idx = L - s0.nwg, x = idx & 7, j = idx >> 3, b = 2 * x + ((j >> 3) & 1), q = j & 3; const bool one = ((j >> 2) & 1) == 0;
        const int pm1 = one ? b : q, pn1 = one ? q : b;
        u.pm = in0 ? a.pm : pm1; u.pn = in0 ? a.pn : pn1; u.w = in0 ? 0 : (one ? 1 : 2);
        return in0 || idx < 128; }
    __device__ __forceinline__ void a_ready(const Unit&) const {}
    __device__ __forceinline__ void done(const Unit&) const {}
    __device__ __forceinline__ const char* a_panel(const Unit& u, const Gemm& g, size_t tstep) const { return (const char*)g.A + (u.w == 1 ? dA1 : 0l) + (u.w == 2 ? dA2 : 0l) + (size_t)u.pm * tstep; }
    __device__ __forceinline__ const char* b_panel(const Unit& u, const Gemm& g, size_t tstep) const { return (const char*)g.Bt + (u.w == 1 ? dB1 : 0l) + (u.w == 2 ? dB2 : 0l) + (size_t)u.pn * tstep; }
};
template <class E0, class E1> struct EpiDual {
    static constexpr bool PERM = true, AFTER_DRAIN = false; static constexpr int NST = E0::NST < E1::NST ? E0::NST : E1::NST; static_assert(E0::PERM && E1::PERM && !E0::AFTER_DRAIN && !E1::AFTER_DRAIN, "EpiDual: both epilogues PERM, in-stream");
    E0 e0; E1 e1;
    __device__ __forceinline__ void operator()(const f32x4 (&acc)[2][2][4][2], const Unit& u, int wr, int wc, int fr, int fq) const { if (u.w) e1(acc, u, wr, wc, fr, fq); else e0(acc, u, wr, wc, fr, fq); }
};

typedef float cvt_f32x2 __attribute__((ext_vector_type(2))); typedef __bf16 cvt_bf16x2 __attribute__((ext_vector_type(2)));
__device__ __forceinline__ unsigned cvt_pk_bf16(float lo, float hi) { const cvt_f32x2 v = {lo, hi}; const cvt_bf16x2 b = __builtin_convertvector(v, cvt_bf16x2); return __builtin_bit_cast(unsigned, b); }
typedef float f32x2 __attribute__((ext_vector_type(2)));
__device__ __forceinline__ u32x4 pack8(f32x4 a, f32x4 b) { u32x4 w; w.x = cvt_pk_bf16(a[0], a[1]); w.y = cvt_pk_bf16(a[2], a[3]); w.z = cvt_pk_bf16(b[0], b[1]); w.w = cvt_pk_bf16(b[2], b[3]); return w; }
__device__ __forceinline__ float rsq4(const float* rs, int row) { return rsqrtf(((rs[row] + rs[32768 + row]) + (rs[65536 + row] + rs[98304 + row])) * (1.f / 1024) + 1e-6f); }
template <int RSM> struct EpiPlainT {
    static constexpr bool PERM = true, AFTER_DRAIN = false; static constexpr int NST = 16;
    bf16_t* O; size_t ldc; float scale; const float* rs;
    __device__ __forceinline__ void operator()(const f32x4 (&acc)[2][2][4][2], const Unit& u, int wr, int wc, int, int) const {
        int ln_ = lane_id(); asm volatile("" : "+v"(ln_)); const int fr = ln_ & 15, fq = ln_ >> 4;
        const int row0 = u.pm * BM + wr * 64 + fr, col0 = u.pn * BM + wc * 32 + 8 * fq;
        f32x4 cs[2][2]; float srv[2][4];
        if (RSM == 1) {
#pragma unroll
            for (int ai = 0; ai < 2; ++ai)
#pragma unroll
                for (int m = 0; m < 4; ++m) srv[ai][m] = rsq4(rs, row0 + ai * HALF + m * 16) * scale; }
        if (RSM == 2) {
#pragma unroll
            for (int bj = 0; bj < 2; ++bj) { f32x4 a_ = (*(const f32x4*)(rs + col0 + bj * HALF) + *(const f32x4*)(rs + 32768 + col0 + bj * HALF)) + (*(const f32x4*)(rs + 65536 + col0 + bj * HALF) + *(const f32x4*)(rs + 98304 + col0 + bj * HALF));
                f32x4 b_ = (*(const f32x4*)(rs + col0 + bj * HALF + 4) + *(const f32x4*)(rs + 32768 + col0 + bj * HALF + 4)) + (*(const f32x4*)(rs + 65536 + col0 + bj * HALF + 4) + *(const f32x4*)(rs + 98304 + col0 + bj * HALF + 4));
#pragma unroll
                for (int j = 0; j < 4; ++j) { a_[j] = rsqrtf(a_[j] * (1.f / 1024) + 1e-6f) * scale; b_[j] = rsqrtf(b_[j] * (1.f / 1024) + 1e-6f) * scale; }
                cs[bj][0] = a_; cs[bj][1] = b_; } }
#pragma unroll
        for (int ai = 0; ai < 2; ++ai)
#pragma unroll
            for (int m = 0; m < 4; ++m) { const int row = row0 + ai * HALF + m * 16; bf16_t* rowp = O + (size_t)row * ldc + col0;
                const float sr = (RSM == 1) ? srv[ai][m] : scale;
#pragma unroll
                for (int bj = 0; bj < 2; ++bj) {
                    if (RSM == 2) *(u32x4*)(rowp + bj * HALF) = pack8(acc[ai][bj][m][0] * cs[bj][0], acc[ai][bj][m][1] * cs[bj][1]);
                    else if (RSM == 0) *(u32x4*)(rowp + bj * HALF) = pack8(acc[ai][bj][m][0], acc[ai][bj][m][1]);
                    else *(u32x4*)(rowp + bj * HALF) = pack8(acc[ai][bj][m][0] * sr, acc[ai][bj][m][1] * sr); } }
    }
};
typedef EpiPlainT<0> EpiPlain;
struct EpiTri {
    static constexpr bool PERM = true, AFTER_DRAIN = false; static constexpr int NST = 16;
    bf16_t* O0; size_t ld0; const float* rs; long dO1, dl1, dO2, dl2;
    __device__ __forceinline__ void operator()(const f32x4 (&acc)[2][2][4][2], const Unit& u, int wr, int wc, int, int) const {
        int ln_ = lane_id(); asm volatile("" : "+v"(ln_)); const int fr = ln_ & 15, fq = ln_ >> 4;
        bf16_t* O = O0 + (u.w == 1 ? dO1 : 0l) + (u.w == 2 ? dO2 : 0l); const size_t ldc = ld0 + (u.w == 1 ? dl1 : 0l) + (u.w == 2 ? dl2 : 0l);
        const int row0 = u.pm * BM + wr * 64 + fr, col0 = u.pn * BM + wc * 32 + 8 * fq;
        float srv[2][4];
#pragma unroll
        for (int ai = 0; ai < 2; ++ai)
#pragma unroll
            for (int m = 0; m < 4; ++m) { srv[ai][m] = 1.f; if (u.w == 0) srv[ai][m] = rsq4(rs, row0 + ai * HALF + m * 16); }
#pragma unroll
        for (int ai = 0; ai < 2; ++ai)
#pragma unroll
            for (int m = 0; m < 4; ++m) { const int row = row0 + ai * HALF + m * 16; bf16_t* rowp = O + (size_t)row * ldc + col0;
                const float sr = srv[ai][m];
#pragma unroll
                for (int bj = 0; bj < 2; ++bj) *(u32x4*)(rowp + bj * HALF) = pack8(acc[ai][bj][m][0] * sr, acc[ai][bj][m][1] * sr); }
    }
};
struct EpiLN {
    static constexpr bool PERM = true, AFTER_DRAIN = false; static constexpr int NST = 16;
    bf16_t* XB; const float* gpost; float* rsq; float* EX; unsigned* tk; PG8_LAS float* red; unsigned colo; float* outf;
    __device__ __forceinline__ void operator()(const f32x4 (&acc)[2][2][4][2], const Unit& u, int wr, int wc, int, int) const {
        int ln_ = lane_id(); asm volatile("" : "+v"(ln_)); const int fr = ln_ & 15, fq = ln_ >> 4;
        const int t = (wr * 4 + wc) * 64 + ln_, rl0 = wr * 64 + fr, col0 = u.pn * BM + wc * 32 + 8 * fq;
        bf16_t* xrow0 = XB + (size_t)(u.pm * BM + rl0) * 1024 + col0;
        u32x4 xw[2][4][2];
#pragma unroll
        for (int ai = 0; ai < 2; ++ai)
#pragma unroll
            for (int m = 0; m < 4; ++m)
#pragma unroll
                for (int bj = 0; bj < 2; ++bj) xw[ai][m][bj] = *(const u32x4*)(xrow0 + (size_t)(ai * HALF + m * 16) * 1024 + bj * HALF);
#pragma unroll
        for (int ai = 0; ai < 2; ++ai)
#pragma unroll
            for (int m = 0; m < 4; ++m) { float p = 0.f;
#pragma unroll
                for (int bj = 0; bj < 2; ++bj)
#pragma unroll
                    for (int n = 0; n < 2; ++n) { const f32x4 v = acc[ai][bj][m][n]; p += (v[0] * v[0] + v[1] * v[1]) + (v[2] * v[2] + v[3] * v[3]); }
                p += __builtin_bit_cast(float, __builtin_amdgcn_ds_bpermute(((ln_ ^ 16) << 2), __builtin_bit_cast(int, p))); p += __builtin_bit_cast(float, __builtin_amdgcn_ds_bpermute(((ln_ ^ 32) << 2), __builtin_bit_cast(int, p)));
                if (fq == 0) red[wc * 256 + rl0 + ai * HALF + m * 16] = p; }
        asm volatile("s_waitcnt lgkmcnt(0)\n\ts_barrier" ::: "memory");
        float* exp_ = EX + (size_t)(u.pm * 4) * 256;
        if (t < 256) exp_[u.pn * 256 + t] = (red[t] + red[256 + t]) + (red[512 + t] + red[768 + t]);
        asm volatile("s_waitcnt vmcnt(0) lgkmcnt(0)\n\ts_barrier" ::: "memory");
        if (t == 0) { if (!colo) { __builtin_amdgcn_fence(__ATOMIC_RELEASE, "agent"); asm volatile("s_waitcnt vmcnt(0)" ::: "memory"); }
            unsigned* c_ = tk + u.pm * 16; (void)__hip_atomic_fetch_add(c_, 1u, __ATOMIC_RELAXED, __HIP_MEMORY_SCOPE_AGENT);
            unsigned sp_ = 0; while (__hip_atomic_load(c_, __ATOMIC_RELAXED, __HIP_MEMORY_SCOPE_AGENT) < 4u && ++sp_ < (1u << 22)) __builtin_amdgcn_s_sleep(1);
            if (!colo) { __builtin_amdgcn_fence(__ATOMIC_ACQUIRE, "agent"); asm volatile("s_waitcnt vmcnt(0)" ::: "memory"); } }
        asm volatile("s_waitcnt vmcnt(0) lgkmcnt(0)\n\ts_barrier" ::: "memory");
        if (t < 256) { float e_[4];
#pragma unroll
            for (int q = 0; q < 4; ++q) e_[q] = __builtin_bit_cast(float, __hip_atomic_load((const unsigned*)(exp_ + q * 256 + t), __ATOMIC_RELAXED, __HIP_MEMORY_SCOPE_AGENT));
            red[1024 + t] = rsqrtf(((e_[0] + e_[1]) + (e_[2] + e_[3])) * (1.f / 1024) + 1e-6f); }
        f32x4 gp[2][2];
#pragma unroll
        for (int bj = 0; bj < 2; ++bj)
#pragma unroll
            for (int n = 0; n < 2; ++n) gp[bj][n] = *(const f32x4*)(gpost + col0 + bj * HALF + 4 * n);
        asm volatile("s_waitcnt vmcnt(0) lgkmcnt(0)\n\ts_barrier" ::: "memory");
        unsigned zo_ = 0; asm volatile("" : "+v"(zo_)); bf16_t* xst = xrow0 + zo_;
#pragma unroll
        for (int ai = 0; ai < 2; ++ai)
#pragma unroll
            for (int m = 0; m < 4; ++m) { const float inv = red[1024 + rl0 + ai * HALF + m * 16]; float p = 0.f;
#pragma unroll
                for (int bj = 0; bj < 2; ++bj) { const u32x4 w = xw[ai][m][bj];
                    f32x4 x0 = (f32x4){__builtin_bit_cast(float, w.x << 16), __builtin_bit_cast(float, w.x & 0xffff0000u), __builtin_bit_cast(float, w.y << 16), __builtin_bit_cast(float, w.y & 0xffff0000u)};
                    f32x4 x1 = (f32x4){__builtin_bit_cast(float, w.z << 16), __builtin_bit_cast(float, w.z & 0xffff0000u), __builtin_bit_cast(float, w.w << 16), __builtin_bit_cast(float, w.w & 0xffff0000u)};
                    x0 = x0 + acc[ai][bj][m][0] * inv * gp[bj][0]; x1 = x1 + acc[ai][bj][m][1] * inv * gp[bj][1];
                    p += ((x0[0] * x0[0] + x0[1] * x0[1]) + (x0[2] * x0[2] + x0[3] * x0[3])) + ((x1[0] * x1[0] + x1[1] * x1[1]) + (x1[2] * x1[2] + x1[3] * x1[3]));
                    if (outf) { float* op_ = outf + (size_t)(u.pm * BM + rl0 + ai * HALF + m * 16) * 1024 + col0 + bj * HALF + zo_; *(f32x4*)op_ = x0; *(f32x4*)(op_ + 4) = x1; }
                    else *(u32x4*)(xst + (size_t)(ai * HALF + m * 16) * 1024 + bj * HALF) = pack8(x0, x1); }
                p += __builtin_bit_cast(float, __builtin_amdgcn_ds_bpermute(((ln_ ^ 16) << 2), __builtin_bit_cast(int, p))); p += __builtin_bit_cast(float, __builtin_amdgcn_ds_bpermute(((ln_ ^ 32) << 2), __builtin_bit_cast(int, p)));
                if (fq == 0) red[wc * 256 + rl0 + ai * HALF + m * 16] = p; }
        asm volatile("s_waitcnt lgkmcnt(0)\n\ts_barrier" ::: "memory");
        if (t < 256 && !outf) rsq[(size_t)u.pn * 32768 + u.pm * BM + t] = (red[t] + red[256 + t]) + (red[512 + t] + red[768 + t]);
        asm volatile("s_waitcnt lgkmcnt(0)\n\ts_barrier" ::: "memory");
    }
};
struct EpiSplit {
    static constexpr bool PERM = true, AFTER_DRAIN = false; static constexpr int NST = 16;
    bf16_t* O0; size_t ld0; int nt0; bf16_t* O1; size_t ld1; float scale;
    __device__ __forceinline__ void operator()(const f32x4 (&acc)[2][2][4][2], const Unit& u, int wr, int wc, int, int) const {
        int ln_ = lane_id(); asm volatile("" : "+v"(ln_)); const int fr = ln_ & 15, fq = ln_ >> 4;
        const bool second = u.pn >= nt0; bf16_t* base = second ? O1 : O0; const size_t ldc = second ? ld1 : ld0;
        const int row0 = u.pm * BM + wr * 64 + fr, col0 = (second ? u.pn - nt0 : u.pn) * BM + wc * 32 + 8 * fq;
#pragma unroll
        for (int ai = 0; ai < 2; ++ai)
#pragma unroll
            for (int m = 0; m < 4; ++m) { bf16_t* rowp = base + (size_t)(row0 + ai * HALF + m * 16) * ldc + col0;
#pragma unroll
                for (int bj = 0; bj < 2; ++bj) *(u32x4*)(rowp + bj * HALF) = pack8(acc[ai][bj][m][0] * scale, acc[ai][bj][m][1] * scale); }
    }
};
struct EpiSwiGLU {
    static constexpr bool PERM = true, AFTER_DRAIN = false; static constexpr int NST = 8;
    bf16_t* O; size_t ldc; const float* rs;
    __device__ __forceinline__ void operator()(const f32x4 (&acc)[2][2][4][2], const Unit& u, int wr, int wc, int, int) const {
        int ln_ = lane_id(); asm volatile("" : "+v"(ln_)); const int fr = ln_ & 15, fq = ln_ >> 4;
        const int row0 = u.pm * BM + wr * 64 + fr, col0 = u.pn * HALF + wc * 32 + 8 * fq;
        float srv[2][4];
#pragma unroll
        for (int ai = 0; ai < 2; ++ai)
#pragma unroll
            for (int m = 0; m < 4; ++m) srv[ai][m] = rsq4(rs, row0 + ai * HALF + m * 16);
#pragma unroll
        for (int ai = 0; ai < 2; ++ai)
#pragma unroll
            for (int m = 0; m < 4; ++m) { f32x4 h[2]; const float sr = srv[ai][m];
#pragma unroll
                for (int n = 0; n < 2; ++n) { const f32x4 g = acc[ai][0][m][n] * sr, up = acc[ai][1][m][n] * sr;
#pragma unroll
                    for (int j = 0; j < 4; ++j) h[n][j] = g[j] * up[j] * __builtin_amdgcn_rcpf(1.f + __expf(-g[j])); }
                *(u32x4*)(O + (size_t)(row0 + ai * HALF + m * 16) * ldc + col0) = pack8(h[0], h[1]); }
    }
};
struct EpiQKO {
    static constexpr bool PERM = true, AFTER_DRAIN = false; static constexpr int NST = 16;
    bf16_t* QK; bf16_t* OG; float qscale; const float* rs;
    __device__ __forceinline__ void operator()(const f32x4 (&acc)[2][2][4][2], const Unit& u, int wr, int wc, int, int) const {
        int ln_ = lane_id(); asm volatile("" : "+v"(ln_)); const int fr = ln_ & 15, fq = ln_ >> 4;
        const int row0 = u.pm * BM + wr * 64 + fr; const bool gate = u.pn >= 4;
        bf16_t* base = gate ? OG : QK; const int col0 = (gate ? u.pn - 4 : u.pn) * BM + wc * 32 + 8 * fq; const float sc = u.pn < 2 ? qscale : 1.f;
        float srv[2][4];
#pragma unroll
        for (int ai = 0; ai < 2; ++ai)
#pragma unroll
            for (int m = 0; m < 4; ++m) srv[ai][m] = sc * rsq4(rs, row0 + ai * HALF + m * 16);
#pragma unroll
        for (int ai = 0; ai < 2; ++ai)
#pragma unroll
            for (int m = 0; m < 4; ++m) { bf16_t* rowp = base + (size_t)(row0 + ai * HALF + m * 16) * 1024 + col0;
#pragma unroll
                for (int bj = 0; bj < 2; ++bj) { const float sr = srv[ai][m]; f32x4 v0 = acc[ai][bj][m][0] * sr, v1 = acc[ai][bj][m][1] * sr;
                    if (gate) {
#pragma unroll
                        for (int j = 0; j < 4; ++j) { v0[j] = __builtin_amdgcn_rcpf(1.f + __expf(-v0[j])); v1[j] = __builtin_amdgcn_rcpf(1.f + __expf(-v1[j])); } }
                    *(u32x4*)(rowp + bj * HALF) = pack8(v0, v1); } }
    }
};

template <class Epi, class Sched, bool ALIGN_EPI = false, bool SP2 = false>
__device__ __forceinline__ void gemm_phase(PG8_LAS unsigned char* lds, const Gemm g, const Sched& S, const Epi& E, const int wave_s) {
    int tid_l = wave_s * 64 + lane_id(); asm volatile("" : "+v"(tid_l));
    const int tid = tid_l, wid = __builtin_amdgcn_readfirstlane(tid >> 6), lane = tid & 63, wr = wid >> 2, wc = wid & 3, fr = lane & 15, fq = lane >> 4;
    const int K = g.K, nt = K / BK;
    unsigned voffA[2], voffB[2];
#pragma unroll
    for (int i = 0; i < 2; ++i) { int R, C; stage_rc(tid * 16 + i * 8192, R, C); const int Rb = Epi::PERM ? ((R & ~31) + perm32(R & 31)) : R;
        voffA[i] = (unsigned)(R * K + C) * 2u; voffB[i] = (unsigned)(Rb * K + C) * 2u; }
    const size_t kstep = (size_t)(BK * 2);
    const size_t hstep = (size_t)HALF * K * 2;
    const size_t tstep = 2 * hstep;
    const unsigned ldsw = (unsigned)wid * 1024u;
    const int aoff = lds_byte(wr * 64 + fr, fq * 8), boff = lds_byte(wc * 32 + fr, fq * 8);
#define PG8_SA(b, h) (((b) * 2 + (h)) * HTB)
#define PG8_SB(b, h) ((4 + (b) * 2 + (h)) * HTB)
#define PG8_STAGE(bufoff, gbase, voff) do { _Pragma("unroll") for (int _i = 0; _i < 2; ++_i) \
        __builtin_amdgcn_global_load_lds((const unsigned*)((const char*)(gbase) + (voff)[_i]), (PG8_LAS unsigned*)(lds + (bufoff) + ldsw + _i * 8192), 16, 0, 0); } while (0)
#define PG8_LDA(dst, b, h) do { _Pragma("unroll") for (int m = 0; m < 4; ++m) _Pragma("unroll") for (int k = 0; k < 2; ++k) dst[m][k] = *(const PG8_LAS bf16x8*)(lds + PG8_SA(b, h) + aoff + m * 2048 + k * 1024); } while (0)
#define PG8_LDB(dst, b, h) do { _Pragma("unroll") for (int n = 0; n < 2; ++n) _Pragma("unroll") for (int k = 0; k < 2; ++k) dst[n][k] = *(const PG8_LAS bf16x8*)(lds + PG8_SB(b, h) + boff + n * 2048 + k * 1024); } while (0)
#define PG8_MMA(ai, bj, At, Bt) do { __builtin_amdgcn_s_setprio(1); _Pragma("unroll") for (int m = 0; m < 4; ++m) _Pragma("unroll") for (int n = 0; n < 2; ++n) _Pragma("unroll") for (int k = 0; k < 2; ++k) \
        acc[ai][bj][m][n] = __builtin_amdgcn_mfma_f32_16x16x32_bf16(Bt[n][k], At[m][k], acc[ai][bj][m][n], 0, 0, 0); __builtin_amdgcn_s_setprio(0); } while (0)
#define PG8_WAIT_V(n) asm volatile("s_waitcnt vmcnt(" #n ")" ::: "memory")
#define PG8_WAIT_VN(n) asm volatile("s_waitcnt vmcnt(%0)" :: "n"(n) : "memory")
    constexpr bool HOIST = ALIGN_EPI && SP2 && !Epi::AFTER_DRAIN;
#define PG8_WAIT_L(n) asm volatile("s_waitcnt lgkmcnt(" #n ")" ::: "memory")
#define PG8_BAR __builtin_amdgcn_s_barrier()
#define PG8_SCHED __builtin_amdgcn_sched_barrier(0)
    Unit cur, nxt; int ui = 0;
    if (!S.next(0, cur)) return;
    f32x4 acc[2][2][4][2];
#pragma unroll
    for (int a = 0; a < 2; ++a)
#pragma unroll
        for (int b = 0; b < 2; ++b)
#pragma unroll
            for (int m = 0; m < 4; ++m)
#pragma unroll
                for (int n = 0; n < 2; ++n) acc[a][b][m][n] = (f32x4){0.f, 0.f, 0.f, 0.f};
    bf16x8 At[4][2], B0[2][2], B1[2][2];
    const char* cA = S.a_panel(cur, g, tstep); const char* cB = S.b_panel(cur, g, tstep);
    S.a_ready(cur);
    if constexpr (SP2) {
        PG8_STAGE(PG8_SB(0, 0), cB, voffB); PG8_STAGE(PG8_SB(0, 1), cB + hstep, voffB); PG8_STAGE(PG8_SA(0, 0), cA, voffA); PG8_STAGE(PG8_SA(0, 1), cA + hstep, voffA);
        if (wr == 1) PG8_BAR;
        PG8_WAIT_V(2); PG8_BAR;
        PG8_STAGE(PG8_SB(1, 0), cB + kstep, voffB); PG8_STAGE(PG8_SA(1, 0), cA + kstep, voffA); PG8_STAGE(PG8_SB(1, 1), cB + hstep + kstep, voffB);
        PG8_WAIT_V(6); PG8_BAR;
    } else {
        PG8_STAGE(PG8_SB(0, 0), cB, voffB); PG8_STAGE(PG8_SA(0, 0), cA, voffA); PG8_STAGE(PG8_SB(0, 1), cB + hstep, voffB); PG8_STAGE(PG8_SA(0, 1), cA + hstep, voffA);
        if (wr == 1) PG8_BAR;
        PG8_WAIT_V(4); PG8_BAR;
        PG8_STAGE(PG8_SB(1, 0), cB + kstep, voffB); PG8_STAGE(PG8_SA(1, 0), cA + kstep, voffA); PG8_STAGE(PG8_SB(1, 1), cB + hstep + kstep, voffB);
        PG8_WAIT_V(6); PG8_BAR;
    }
    for (;;) {
        const bool has_next = S.next(ui + 1, nxt);
        const char* nA = has_next ? S.a_panel(nxt, g, tstep) : cA; const char* nB = has_next ? S.b_panel(nxt, g, tstep) : cB;
#pragma nounroll
        for (int t = 0; t < nt; t += 2) {
            const bool last = (t == nt - 2), first = HOIST && (t == 0) && (ui > 0);
            const char* a1 = cA + (size_t)(t + 1) * kstep;
            const char* a2 = last ? nA : cA + (size_t)(t + 2) * kstep; const char* b2 = last ? nB : cB + (size_t)(t + 2) * kstep;
            const char* a3 = a2 + kstep; const char* b3 = b2 + kstep;
            if (last && has_next) S.a_ready(nxt);
            if constexpr (SP2) {
            PG8_LDB(B0, 0, 0); PG8_LDB(B1, 0, 1); PG8_SCHED; PG8_LDA(At, 0, 0); if (!first) PG8_STAGE(PG8_SA(1, 1), a1 + hstep, voffA);
            if (first) PG8_WAIT_VN(8 + Epi::NST); else PG8_WAIT_V(8); PG8_WAIT_L(0); PG8_BAR; PG8_MMA(0, 0, At, B0); PG8_MMA(0, 1, At, B1); PG8_BAR; PG8_SCHED;
            PG8_LDA(At, 0, 1); PG8_STAGE(PG8_SB(0, 0), b2, voffB); PG8_STAGE(PG8_SB(0, 1), b2 + hstep, voffB); PG8_STAGE(PG8_SA(0, 0), a2, voffA);
            if (first) PG8_WAIT_VN(8 + Epi::NST); else PG8_WAIT_V(8); PG8_WAIT_L(0); PG8_BAR; PG8_MMA(1, 0, At, B0); PG8_MMA(1, 1, At, B1); PG8_BAR; PG8_SCHED;
            PG8_LDB(B0, 1, 0); PG8_LDB(B1, 1, 1); PG8_SCHED; PG8_LDA(At, 1, 0); PG8_STAGE(PG8_SA(0, 1), a2 + hstep, voffA);
            if (first) PG8_WAIT_VN(8 + Epi::NST); else PG8_WAIT_V(8); PG8_WAIT_L(0); PG8_BAR; PG8_MMA(0, 0, At, B0); PG8_MMA(0, 1, At, B1); PG8_BAR; PG8_SCHED;
            PG8_LDA(At, 1, 1); PG8_STAGE(PG8_SB(1, 0), b3, voffB); PG8_STAGE(PG8_SB(1, 1), b3 + hstep, voffB); PG8_STAGE(PG8_SA(1, 0), a3, voffA);
            PG8_WAIT_V(8); PG8_WAIT_L(0); PG8_BAR; PG8_MMA(1, 0, At, B0); PG8_MMA(1, 1, At, B1); PG8_BAR; PG8_SCHED;
            } else {
            PG8_LDB(B0, 0, 0); PG8_SCHED; PG8_LDA(At, 0, 0); PG8_STAGE(PG8_SA(1, 1), a1 + hstep, voffA);
            PG8_WAIT_L(8); PG8_BAR; PG8_WAIT_L(0); PG8_MMA(0, 0, At, B0); PG8_BAR; PG8_SCHED;
            PG8_LDB(B1, 0, 1); PG8_STAGE(PG8_SB(0, 0), b2, voffB);
            PG8_BAR; PG8_WAIT_L(0); PG8_MMA(0, 1, At, B1); PG8_BAR;
            PG8_LDA(At, 0, 1); PG8_STAGE(PG8_SA(0, 0), a2, voffA);
            PG8_BAR; PG8_WAIT_L(0); PG8_MMA(1, 0, At, B0); PG8_BAR; PG8_SCHED;
            PG8_STAGE(PG8_SB(0, 1), b2 + hstep, voffB);
            PG8_WAIT_V(6); PG8_BAR; PG8_MMA(1, 1, At, B1); PG8_BAR;
            PG8_LDB(B0, 1, 0); PG8_SCHED; PG8_LDA(At, 1, 0); PG8_STAGE(PG8_SA(0, 1), a2 + hstep, voffA);
            PG8_WAIT_L(8); PG8_BAR; PG8_WAIT_L(0); PG8_MMA(0, 0, At, B0); PG8_BAR; PG8_SCHED;
            PG8_LDB(B1, 1, 1); PG8_STAGE(PG8_SB(1, 0), b3, voffB);
            PG8_BAR; PG8_WAIT_L(0); PG8_MMA(0, 1, At, B1); PG8_BAR;
            PG8_LDA(At, 1, 1); PG8_STAGE(PG8_SA(1, 0), a3, voffA);
            PG8_BAR; PG8_WAIT_L(0); PG8_MMA(1, 0, At, B0); PG8_BAR; PG8_SCHED;
            PG8_STAGE(PG8_SB(1, 1), b3 + hstep, voffB);
            PG8_WAIT_V(6); PG8_BAR; PG8_MMA(1, 1, At, B1); PG8_BAR;
            }
        }
        if constexpr (ALIGN_EPI) { if (wr == 0) PG8_BAR; }
        if constexpr (HOIST) { if (has_next) PG8_STAGE(PG8_SA(1, 1), nA + kstep + hstep, voffA); }
        if constexpr (!Epi::AFTER_DRAIN) { E(acc, cur, wr, wc, fr, fq); S.done(cur); }
        if (!has_next) break;
#pragma unroll
        for (int a = 0; a < 2; ++a)
#pragma unroll
            for (int b = 0; b < 2; ++b)
#pragma unroll
                for (int m = 0; m < 4; ++m)
#pragma unroll
                    for (int n = 0; n < 2; ++n) acc[a][b][m][n] = (f32x4){0.f, 0.f, 0.f, 0.f};
        cur = nxt; cA = nA; cB = nB; ++ui;
        if constexpr (ALIGN_EPI) { if (wr == 1) PG8_BAR; }
    }
    PG8_WAIT_V(0);
    if constexpr (!ALIGN_EPI) { if (wr == 0) PG8_BAR; }
    PG8_BAR;
    if constexpr (Epi::AFTER_DRAIN) { E.fused(acc, cur, wr, wc, fr, fq, lds, wid, lane); S.done(cur); }
#undef PG8_SA
#undef PG8_SB
#undef PG8_STAGE
#undef PG8_LDA
#undef PG8_LDB
#undef PG8_MMA
#undef PG8_WAIT_V
#undef PG8_WAIT_VN
#undef PG8_WAIT_L
#undef PG8_BAR
#undef PG8_SCHED
}
}

constexpr int D = 1024, NB = 16, SEQ = 2048, M = NB * SEQ, DEPTH = 4;
constexpr int NMEM = 256, MMEM = NB * NMEM;
constexpr int DFF = 2816;
constexpr int MLA_H = 8, QRANK = 384, KVRANK = 256, MLA_IN = 704, MLA_INP = 768;
constexpr int LH = 4, LDK = 128, LDV = 256;
constexpr int MLSTM_IN = 3080;
constexpr float EPS = 1e-6f;
constexpr float LOG2E = 1.4426950408889634f;
constexpr float MLA_QS = 0.07216878364870322f * LOG2E;
constexpr float MEM_QS = 0.0625f * LOG2E;
constexpr float LQ_S = 0.08838834764831845f;
constexpr int NWAVES = 8;
constexpr int GTOK = M / 8;
constexpr int VT_LD = GTOK + 64, KVT_LD = GTOK + 64, VMT_LD = MMEM + 64;

constexpr size_t MiB = 1u << 20;
constexpr size_t WS_CTL = 0, CTL_ZERO_BYTES = 1 * MiB;
constexpr size_t WS_COS = 1 * MiB, WS_SIN = 5 * MiB;
constexpr size_t WS_GATES = 9 * MiB;
constexpr size_t WS_RS = 10 * MiB;
constexpr size_t WS_EX = 12 * MiB + MiB / 2;
constexpr size_t WS_W = 16 * MiB;
constexpr size_t WS_KM = 144 * MiB;
constexpr size_t WS_VMT = 176 * MiB;
constexpr size_t WS_HN = 212 * MiB;
constexpr size_t WS_BIG = 276 * MiB;
constexpr size_t WS_END = 512 * MiB;
constexpr size_t WE_MLA_IN = 0, WE_MLA_UQ = WE_MLA_IN + (size_t)MLA_INP * D, WE_MLA_UKV = WE_MLA_UQ + (size_t)1536 * QRANK, WE_MLA_O = WE_MLA_UKV + (size_t)2048 * KVRANK, WE_MLA_SZ = WE_MLA_O + (size_t)D * D;
constexpr size_t WE_L_IN = 0, WE_L_O = (size_t)3584 * D, WE_L_SZ = WE_L_O + (size_t)D * D;
constexpr size_t WE_M_Q = 0, WE_M_KV = (size_t)D * D, WE_M_O = WE_M_KV + (size_t)2048 * D, WE_M_SZ = WE_M_O + (size_t)D * D;
constexpr size_t WE_F_GU = 0, WE_F_D = (size_t)2 * DFF * D, WE_F_SZ = WE_F_D + (size_t)D * DFF;
constexpr size_t WE_MLA = 0, WE_L = WE_MLA + 2 * WE_MLA_SZ, WE_M = WE_L + 2 * WE_L_SZ, WE_F = WE_M + 4 * WE_M_SZ, WE_TOTAL = WE_F + 4 * WE_F_SZ;
static_assert(WS_W + WE_TOTAL * 2 <= WS_KM, "weights fit");
constexpr size_t S_GRP = 29 * MiB + MiB / 2;
static_assert(8 * S_GRP <= WS_END - WS_BIG, "slabs fit");
constexpr size_t B_QN = 0, B_QR = 8 * MiB, B_VT = 12 * MiB, B_CQN = 20 * MiB + MiB / 4, B_CKVN = 23 * MiB + MiB / 4, B_KR = 25 * MiB + MiB / 4;
constexpr size_t B_QM = 0;
constexpr size_t B_HID = 0;
constexpr size_t B_QK = 0, B_OG = 8 * MiB, B_KVT = 16 * MiB;
constexpr size_t B_MEMN0 = 27 * MiB, B_MEMN2 = 28 * MiB + MiB / 4;
static_assert(B_VT + (size_t)D * VT_LD * 2 <= B_CQN && B_KR + (size_t)GTOK * 64 * 2 <= B_MEMN0 && B_KVT + (size_t)1536 * KVT_LD * 2 <= B_MEMN2 && B_HID + (size_t)GTOK * DFF * 2 <= B_MEMN0 && B_MEMN2 + MiB <= S_GRP, "slab map");
static_assert(WS_VMT + (size_t)4 * D * VMT_LD * 2 <= WS_HN, "VMT fits");
__host__ __device__ __forceinline__ constexpr size_t memn_slab_off(int l) { return l == 0 ? B_MEMN0 : (l == 2 ? B_MEMN2 : (l == 1 ? 0 * MiB : 1 * MiB)); }

constexpr int RING_BYTES = 143360;
constexpr int LDSCTL_OFF = RING_BYTES, MISC_OFF = LDSCTL_OFF + 320;
constexpr int LDS_BYTES = 155648;

#define GAS __attribute__((address_space(1)))
#define LAS __attribute__((address_space(3)))
typedef unsigned short bf16;
typedef unsigned v4u __attribute__((ext_vector_type(4)));
typedef float f32x4 __attribute__((ext_vector_type(4)));
typedef short bf16x8 __attribute__((ext_vector_type(8)));
typedef GAS unsigned gu32;
typedef GAS unsigned long long gu64;
#define RLX_AGENT __ATOMIC_RELAXED, __HIP_MEMORY_SCOPE_AGENT
#define LDS_WAIT() asm volatile("s_waitcnt lgkmcnt(0)" ::: "memory")
#define VM_WAIT() asm volatile("s_waitcnt vmcnt(0)" ::: "memory")
__device__ __forceinline__ unsigned long long rt() { return __builtin_amdgcn_s_memrealtime(); }
__device__ __forceinline__ unsigned f2bf(float f) { unsigned u = __builtin_bit_cast(unsigned, f); return (u + 0x7fffu + ((u >> 16) & 1u)) >> 16; }
__device__ __forceinline__ unsigned pk2(float lo, float hi) { return f2bf(lo) | (f2bf(hi) << 16); }

#define XB_TMO      128
#define XB_XCNT(j)  (256  + 64 * (j))
#define XB_XSUB(j)  (1280 + 64 * (j))
#define XB_XGEN(j)  (2304 + 64 * (j))
#define XB_TOP      3328
#define XB_TOPGEN   3392
#define XB_XG64(j)  (3456 + 64 * (j))
#define XB_GCNT(j)  (4480 + 64 * (j))
#define XCD_BAR_WORDS 5504
#define XB_SPIN_CAP (1u << 18)

__device__ __forceinline__ unsigned xb_ld(unsigned* p)              { return __hip_atomic_load(p, __ATOMIC_RELAXED, __HIP_MEMORY_SCOPE_AGENT); }
__device__ __forceinline__ unsigned xb_add(unsigned* p, unsigned v) { return __hip_atomic_fetch_add(p, v, __ATOMIC_RELAXED, __HIP_MEMORY_SCOPE_AGENT); }
__device__ __forceinline__ unsigned xb_xcc_id() { return (unsigned)__builtin_amdgcn_s_getreg((3 << 11) | 20) & 0xFu; }
#define XB_SPIN(cond, bar) do { unsigned _sp = 0; while (cond) { __builtin_amdgcn_s_sleep(1); \
    if ((++_sp & 255u) == 0u) { if (xb_ld(&(bar)[XB_TMO])) break; if (_sp > XB_SPIN_CAP) { atomicAdd(&(bar)[XB_TMO], 1u); break; } } } } while (0)

struct XcdBarrier {
    unsigned* bar; unsigned x;
    volatile LAS unsigned* st;
};

__device__ __forceinline__ XcdBarrier xcd_barrier_post(unsigned* bar, volatile LAS unsigned* st, const int wave_s) {
    XcdBarrier b; b.bar = bar; b.x = xb_xcc_id(); b.st = st;
    if (wave_s == 0 && pg8::lane_id() == 0) { (void)xb_add(&bar[XB_XCNT(b.x)], 1u);
        (void)__hip_atomic_fetch_add((unsigned long long*)&bar[XB_XG64(b.x)], 1ull | (1ull << (16 + 6 * (blockIdx.x & 7u))), __ATOMIC_RELAXED, __HIP_MEMORY_SCOPE_AGENT); }
    return b;
}
__device__ __forceinline__ void xcd_barrier_complete(unsigned* bar, unsigned x, unsigned& nloc, unsigned& nx) {
    const unsigned G = gridDim.x * gridDim.y * gridDim.z;
    unsigned sum, cnt, mine, sp = 0u;
    for (;;) {
        sum = 0u; cnt = 0u; mine = 0u;
#pragma unroll
        for (unsigned j = 0; j < 16; ++j) { const unsigned c = xb_ld(&bar[XB_XCNT(j)]); sum += c; cnt += (c > 0u) ? 1u : 0u; mine = (j == x) ? c : mine; }
        if (sum == G) break;
        __builtin_amdgcn_s_sleep(1);
        if ((++sp & 255u) == 0u) { if (xb_ld(&bar[XB_TMO])) break; if (sp > XB_SPIN_CAP) { atomicAdd(&bar[XB_TMO], 1u); break; } }
    }
    nloc = mine > 0u ? mine : 1u; nx = cnt > 0u ? cnt : 1u;
}

__device__ __forceinline__ unsigned xcd_groups_colocated(unsigned* bar) {
    const unsigned G = gridDim.x * gridDim.y * gridDim.z; if (G != 256u) return 0u;
    unsigned long long w[16]; unsigned sp = 0u;
    for (;;) { unsigned sum = 0u;
#pragma unroll
        for (unsigned j = 0; j < 16; ++j) { w[j] = __hip_atomic_load((unsigned long long*)&bar[XB_XG64(j)], __ATOMIC_RELAXED, __HIP_MEMORY_SCOPE_AGENT); sum += (unsigned)(w[j] & 0xffffull); }
        if (sum == G) break;
        __builtin_amdgcn_s_sleep(1);
        if ((++sp & 255u) == 0u) { if (xb_ld(&bar[XB_TMO])) return 0u; if (sp > XB_SPIN_CAP) { atomicAdd(&bar[XB_TMO], 1u); return 0u; } } }
    unsigned ok = 1u;
#pragma unroll
    for (unsigned j = 0; j < 16; ++j) { const unsigned cnt = (unsigned)(w[j] & 0xffffull); if (cnt == 0u) continue; unsigned one = 0u;
#pragma unroll
        for (unsigned g = 0; g < 8; ++g) one += (((unsigned)(w[j] >> (16 + 6 * g)) & 63u) == 32u) ? 1u : 0u;
        if (cnt != 32u || one != 1u) ok = 0u; }
    return ok;
}

__device__ __forceinline__ void xcd_barrier(const XcdBarrier& b, const int wave_s) {
    asm volatile("s_waitcnt vmcnt(0)" ::: "memory");
    __syncthreads();
    if (wave_s == 0 && pg8::lane_id() == 0) {
        unsigned* bar = b.bar;
        __builtin_amdgcn_s_waitcnt(0);
        unsigned nloc = b.st[0], nx = b.st[1];
        if (nloc == 0u) { xcd_barrier_complete(bar, b.x, nloc, nx); b.st[0] = nloc; b.st[1] = nx; b.st[2] = xcd_groups_colocated(bar); }
        const unsigned old = xb_add(&bar[XB_XSUB(b.x)], 1u);
        const unsigned gen = old / nloc;
        if (old + 1u == (gen + 1u) * nloc) {
            __builtin_amdgcn_fence(__ATOMIC_RELEASE, "agent");
            asm volatile("s_waitcnt vmcnt(0)" ::: "memory");
            const unsigned og = xb_add(&bar[XB_TOP], 1u);
            const unsigned tg = og / nx;
            if (og + 1u == (tg + 1u) * nx) xb_add(&bar[XB_TOPGEN], 1u);
            else XB_SPIN(xb_ld(&bar[XB_TOPGEN]) == tg, bar);
            __builtin_amdgcn_fence(__ATOMIC_ACQUIRE, "agent");
            xb_add(&bar[XB_XGEN(b.x)], 1u);
            asm volatile("s_waitcnt vmcnt(0)" ::: "memory");
        } else {
            XB_SPIN(xb_ld(&bar[XB_XGEN(b.x)]) == gen, bar);
            __builtin_amdgcn_fence(__ATOMIC_ACQUIRE, "agent");
            asm volatile("s_waitcnt vmcnt(0)" ::: "memory");
        }
    }
    __syncthreads();
}

__device__ __forceinline__ void grp_barrier(const XcdBarrier& b, const int wave_s) {
    asm volatile("s_waitcnt vmcnt(0)" ::: "memory");
    __syncthreads();
    if (wave_s == 0 && pg8::lane_id() == 0) {
        unsigned* bar = b.bar;
        __builtin_amdgcn_s_waitcnt(0);
        const unsigned nloc = b.st[0], nx = b.st[1], colo = b.st[2];
        if (colo) {
            const unsigned k = b.st[3] + 1u; b.st[3] = k;
            asm volatile("buffer_inv sc1" ::: "memory");
            (void)__hip_atomic_fetch_add(&bar[XB_GCNT(b.x)], 1u, __ATOMIC_RELAXED, __HIP_MEMORY_SCOPE_AGENT);
            const unsigned target = k * nloc;
            XB_SPIN(xb_ld(&bar[XB_GCNT(b.x)]) < target, bar);
            asm volatile("s_waitcnt vmcnt(0)" ::: "memory");
        } else {
            const unsigned old = xb_add(&bar[XB_XSUB(b.x)], 1u);
            const unsigned gen = old / nloc;
            if (old + 1u == (gen + 1u) * nloc) {
                __builtin_amdgcn_fence(__ATOMIC_RELEASE, "agent");
                asm volatile("s_waitcnt vmcnt(0)" ::: "memory");
                const unsigned og = xb_add(&bar[XB_TOP], 1u);
                const unsigned tg = og / nx;
                if (og + 1u == (tg + 1u) * nx) xb_add(&bar[XB_TOPGEN], 1u);
                else XB_SPIN(xb_ld(&bar[XB_TOPGEN]) == tg, bar);
                __builtin_amdgcn_fence(__ATOMIC_ACQUIRE, "agent");
                xb_add(&bar[XB_XGEN(b.x)], 1u);
                asm volatile("s_waitcnt vmcnt(0)" ::: "memory");
            } else {
                XB_SPIN(xb_ld(&bar[XB_XGEN(b.x)]) == gen, bar);
                __builtin_amdgcn_fence(__ATOMIC_ACQUIRE, "agent");
                asm volatile("s_waitcnt vmcnt(0)" ::: "memory");
            }
        }
    }
    __syncthreads();
}
__device__ __forceinline__ int opq_s(int x) { asm volatile("" : "+s"(x)); return x; }
typedef unsigned u32x4 __attribute__((ext_vector_type(4)));
typedef unsigned u32x2 __attribute__((ext_vector_type(2)));
template <int K> __device__ __forceinline__ float swz_xor(float v) { return __int_as_float(__builtin_amdgcn_ds_swizzle(__float_as_int(v), (K << 10) | 0x1f)); }
__device__ __forceinline__ float xor32(float v, bool mx) { auto rr = __builtin_amdgcn_permlane32_swap(__float_as_uint(v), __float_as_uint(v), false, false);
    const float a = __uint_as_float(rr[0]), b = __uint_as_float(rr[1]); return mx ? fmaxf(a, b) : a + b; }
template <int CTRL> __device__ __forceinline__ float dpp_x(float v) { return __int_as_float(__builtin_amdgcn_update_dpp(0, __float_as_int(v), CTRL, 0xf, 0xf, true)); }
__device__ __forceinline__ float xor16(float v, bool mx) { auto rr = __builtin_amdgcn_permlane16_swap(__float_as_uint(v), __float_as_uint(v), false, false);
    const float a = __uint_as_float(rr[0]), b = __uint_as_float(rr[1]); return mx ? fmaxf(a, b) : a + b; }
__device__ __forceinline__ float half_sum(float v) {
    v += dpp_x<0xB1>(v); v += dpp_x<0x4E>(v); v += dpp_x<0x141>(v); v += dpp_x<0x140>(v); return xor16(v, false);
}
__device__ __forceinline__ float wave_sum(float v) { return xor32(half_sum(v), false); }
__device__ __forceinline__ float wave_max(float v) {
    v = fmaxf(v, dpp_x<0xB1>(v)); v = fmaxf(v, dpp_x<0x4E>(v)); v = fmaxf(v, dpp_x<0x141>(v)); v = fmaxf(v, dpp_x<0x140>(v)); return xor32(xor16(v, true), true);
}
__device__ __forceinline__ float bflo(unsigned w) { return __uint_as_float(w << 16); }
__device__ __forceinline__ float bfhi(unsigned w) { return __uint_as_float(w & 0xffff0000u); }
__device__ __forceinline__ float bf2f(bf16 b) { return __uint_as_float((unsigned)b << 16); }
__device__ __forceinline__ void load_row_f32(const float* p, int lane, f32x4 (&v)[4]) {
#pragma unroll
    for (int j = 0; j < 4; ++j) v[j] = *(const f32x4*)(p + 4 * lane + 256 * j);
}
__device__ __forceinline__ void load_row_bf16(const bf16* p, int lane, f32x4 (&v)[4]) {
#pragma unroll
    for (int j = 0; j < 4; ++j) { const u32x2 w = *(const u32x2*)(p + 4 * lane + 256 * j); v[j] = (f32x4){bflo(w.x), bfhi(w.x), bflo(w.y), bfhi(w.y)}; }
}
__device__ __forceinline__ void store_row_bf16(bf16* p, int lane, const f32x4 (&v)[4]) {
#pragma unroll
    for (int j = 0; j < 4; ++j) { u32x2 w; w.x = pg8::cvt_pk_bf16(v[j][0], v[j][1]); w.y = pg8::cvt_pk_bf16(v[j][2], v[j][3]); *(u32x2*)(p + 4 * lane + 256 * j) = w; }
}
__device__ __forceinline__ void load_row8_f32(const float* p, int lane, f32x4 (&v)[4]) {
#pragma unroll
    for (int j = 0; j < 2; ++j) { v[2 * j] = *(const f32x4*)(p + 8 * lane + 512 * j); v[2 * j + 1] = *(const f32x4*)(p + 8 * lane + 512 * j + 4); }
}
__device__ __forceinline__ void load_row8_bf16(const bf16* p, int lane, f32x4 (&v)[4]) {
#pragma unroll
    for (int j = 0; j < 2; ++j) { const u32x4 w = *(const u32x4*)(p + 8 * lane + 512 * j); v[2 * j] = (f32x4){bflo(w.x), bfhi(w.x), bflo(w.y), bfhi(w.y)}; v[2 * j + 1] = (f32x4){bflo(w.z), bfhi(w.z), bflo(w.w), bfhi(w.w)}; }
}
__device__ __forceinline__ void store_row8_bf16(bf16* p, int lane, const f32x4 (&v)[4]) {
#pragma unroll
    for (int j = 0; j < 2; ++j) { u32x4 w; w.x = pg8::cvt_pk_bf16(v[2 * j][0], v[2 * j][1]); w.y = pg8::cvt_pk_bf16(v[2 * j][2], v[2 * j][3]); w.z = pg8::cvt_pk_bf16(v[2 * j + 1][0], v[2 * j + 1][1]); w.w = pg8::cvt_pk_bf16(v[2 * j + 1][2], v[2 * j + 1][3]);
        *(u32x4*)(p + 8 * lane + 512 * j) = w; }
}
__device__ __forceinline__ float row_ssq(const f32x4 (&v)[4]) {
    float s = 0.f;
#pragma unroll
    for (int j = 0; j < 4; ++j) s += (v[j][0] * v[j][0] + v[j][1] * v[j][1]) + (v[j][2] * v[j][2] + v[j][3] * v[j][3]);
    return wave_sum(s);
}
__device__ __forceinline__ float log_sigmoid(float x) { return fminf(x, 0.f) - log1pf(__expf(-fabsf(x))); }

enum { CK_ID = 0, CK_MLA_IN, CK_MLA_UQ, CK_MLA_UKV, CK_L_IN, CK_F_GU };
__device__ __forceinline__ int src_col(int kind, int n) {
    switch (kind) {
    case CK_MLA_IN: return n < MLA_IN ? n : -1;
    case CK_MLA_UQ: if (n < 1024) return 192 * (n >> 7) + (n & 127); else { const int r = n - 1024; return 192 * (r >> 6) + 128 + (r & 63); }
    case CK_MLA_UKV: if (n < 1024) return 256 * (n >> 7) + (n & 127); else { const int r = n - 1024; return 256 * (r >> 7) + 128 + (r & 127); }
    case CK_L_IN: if (n < 1024) return n; if (n < 2048) return 2048 + (n - 1024); if (n < 2560) return 512 + (n - 2048); return 1024 + (n - 2560);
    case CK_F_GU: { const int pn = n >> 8, half = (n >> 7) & 1; return half * DFF + 128 * pn + (n & 127); }
    default: return n;
    }
}
__device__ __forceinline__ void cvt_item(const float* W, int K, int Nsrc, int sc, bf16* WTrow0, LAS float* scr, int kb, int lane, const float* gk) {
    const int k0 = 64 * kb;
    f32x4 v[8];
    if (sc >= 0) { const float* src = W + (size_t)(k0 + lane) * Nsrc + sc; const float g = gk ? gk[k0 + lane] : 1.f;
#pragma unroll
        for (int i = 0; i < 8; ++i) v[i] = *(const f32x4*)(src + 4 * i) * g;
    } else {
#pragma unroll
        for (int i = 0; i < 8; ++i) v[i] = (f32x4){0.f, 0.f, 0.f, 0.f};
    }
#pragma unroll
    for (int i = 0; i < 8; ++i)
#pragma unroll
        for (int e = 0; e < 4; ++e) scr[(4 * i + e) * 68 + lane] = v[i][e];
    LDS_WAIT(); asm volatile("" ::: "memory");
    const int n = lane >> 1, half = lane & 1; const LAS float* s = scr + n * 68 + half * 32;
#pragma unroll
    for (int q = 0; q < 4; ++q) { const f32x4 a = *(const LAS f32x4*)(s + 8 * q), bq = *(const LAS f32x4*)(s + 8 * q + 4);
        u32x4 o; o.x = pg8::cvt_pk_bf16(a[0], a[1]); o.y = pg8::cvt_pk_bf16(a[2], a[3]); o.z = pg8::cvt_pk_bf16(bq[0], bq[1]); o.w = pg8::cvt_pk_bf16(bq[2], bq[3]);
        *(u32x4*)(WTrow0 + (size_t)n * K + k0 + half * 32 + 8 * q) = o; }
    LDS_WAIT(); asm volatile("" ::: "memory");
}

template <int D1, int D2, int DV>
__device__ __forceinline__ void naive_attn_row(const bf16* q1, const bf16* q2, const bf16* k1, size_t k1p, const bf16* k2, size_t k2p, int nk,
                                               const bf16* vt, size_t vtp, bf16* o, LAS float* qs, LAS float* sc, int lane) {
    for (int d = lane; d < D1; d += 64) qs[d] = bf2f(q1[d]);
    if (D2 > 0) for (int d = lane; d < D2; d += 64) qs[D1 + d] = bf2f(q2[d]);
    LDS_WAIT();
    float mx = -1e30f;
    const int nkr = (nk + 63) & ~63;
    for (int kb = 0; kb < nkr; kb += 64) {
        const int key = kb + lane; float s = -__builtin_inff();
        if (key < nk) {
            s = 0.f; const bf16* kr = k1 + (size_t)key * k1p;
            for (int c = 0; c < D1 / 8; ++c) { const u32x4 w = *(const u32x4*)(kr + 8 * c); const LAS float* q = qs + 8 * c;
                s += q[0] * bflo(w.x) + q[1] * bfhi(w.x) + q[2] * bflo(w.y) + q[3] * bfhi(w.y) + q[4] * bflo(w.z) + q[5] * bfhi(w.z) + q[6] * bflo(w.w) + q[7] * bfhi(w.w); }
            if (D2 > 0) { const bf16* kr2 = k2 + (size_t)key * k2p;
                for (int c = 0; c < D2 / 8; ++c) { const u32x4 w = *(const u32x4*)(kr2 + 8 * c); const LAS float* q = qs + D1 + 8 * c;
                    s += q[0] * bflo(w.x) + q[1] * bfhi(w.x) + q[2] * bflo(w.y) + q[3] * bfhi(w.y) + q[4] * bflo(w.z) + q[5] * bfhi(w.z) + q[6] * bflo(w.w) + q[7] * bfhi(w.w); } }
        }
        sc[key] = s; mx = fmaxf(mx, s);
    }
    mx = wave_max(mx);
    float sum = 0.f;
    LDS_WAIT();
    for (int kb = 0; kb < nkr; kb += 64) { const int key = kb + lane; const float p = exp2f(sc[key] - mx); sc[key] = p; sum += p; }
    sum = wave_sum(sum);
    LDS_WAIT();
    const float inv = 1.f / sum;
#pragma unroll
    for (int i = 0; i < DV / 64; ++i) { const int dv = lane + 64 * i; const bf16* vr = vt + (size_t)dv * vtp; float acc = 0.f;
        for (int kb = 0; kb < nkr; kb += 8) { const u32x4 w = *(const u32x4*)(vr + kb); const LAS float* p = sc + kb;
            acc += p[0] * bflo(w.x) + p[1] * bfhi(w.x) + p[2] * bflo(w.y) + p[3] * bfhi(w.y) + p[4] * bflo(w.z) + p[5] * bfhi(w.z) + p[6] * bflo(w.w) + p[7] * bfhi(w.w); }
        o[dv] = (bf16)(pg8::cvt_pk_bf16(acc * inv, 0.f) & 0xffffu); }
    LDS_WAIT();
}

__device__ __forceinline__ void naive_scan_unit(int unit, const bf16* QK, const bf16* KVT, const float* GATES, bf16* HS, LAS unsigned char* lds, int tid, int nchunks = SEQ / 64) {
    const int b = unit >> 4, h = (unit >> 2) & 3, vs = unit & 3;
    LAS float* ql = (LAS float*)lds; LAS float* kl = ql + 64 * 128; LAS float* vl = kl + 64 * 128; LAS float* gl = vl + 64 * 64;
    const int v = tid >> 3, dg = tid & 7;
    float C[16], n[16];
#pragma unroll
    for (int i = 0; i < 16; ++i) { C[i] = 0.f; n[i] = 0.f; }
    float m = 0.f;
    for (int c = 0; c < nchunks; ++c) {
        const size_t tok0 = (size_t)b * SEQ + (size_t)c * 64;
        __syncthreads();
#pragma unroll
        for (int i = 0; i < 2; ++i) { const int ch = tid + 512 * i, t = ch >> 4, c8 = ch & 15;
            const u32x4 wq = *(const u32x4*)(QK + (tok0 + t) * 1024 + h * 128 + c8 * 8); const u32x4 wk = *(const u32x4*)(QK + (tok0 + t) * 1024 + 512 + h * 128 + c8 * 8);
            LAS float* qd = ql + t * 128 + c8 * 8; LAS float* kd = kl + t * 128 + c8 * 8;
            qd[0] = bflo(wq.x); qd[1] = bfhi(wq.x); qd[2] = bflo(wq.y); qd[3] = bfhi(wq.y); qd[4] = bflo(wq.z); qd[5] = bfhi(wq.z); qd[6] = bflo(wq.w); qd[7] = bfhi(wq.w);
            kd[0] = bflo(wk.x); kd[1] = bfhi(wk.x); kd[2] = bflo(wk.y); kd[3] = bfhi(wk.y); kd[4] = bflo(wk.z); kd[5] = bfhi(wk.z); kd[6] = bflo(wk.w); kd[7] = bfhi(wk.w); }
        { const int row = tid >> 3, t8 = tid & 7; const u32x4 w = *(const u32x4*)(KVT + (size_t)(512 + h * 256 + vs * 64 + row) * M + tok0 + t8 * 8);
            LAS float* vd = vl + (t8 * 8) * 64 + row;
            vd[0 * 64] = bflo(w.x); vd[1 * 64] = bfhi(w.x); vd[2 * 64] = bflo(w.y); vd[3 * 64] = bfhi(w.y); vd[4 * 64] = bflo(w.z); vd[5 * 64] = bfhi(w.z); vd[6 * 64] = bflo(w.w); vd[7 * 64] = bfhi(w.w); }
        if (tid < 64) { gl[2 * tid] = GATES[(tok0 + tid) * 8 + h]; gl[2 * tid + 1] = log_sigmoid(GATES[(tok0 + tid) * 8 + 4 + h]); }
        __syncthreads();
        for (int t = 0; t < 64; ++t) {
            const float li = gl[2 * t], lf = gl[2 * t + 1];
            const float mn = fmaxf(lf + m, li), fw = __expf(lf + m - mn), iw = __expf(li - mn); m = mn;
            const float vv = vl[t * 64 + v] * iw;
            float num = 0.f, den = 0.f;
#pragma unroll
            for (int i = 0; i < 16; ++i) { const float kk = kl[t * 128 + dg + 8 * i], qq = ql[t * 128 + dg + 8 * i];
                C[i] = fw * C[i] + vv * kk; n[i] = fw * n[i] + iw * kk; num += C[i] * qq; den += n[i] * qq; }
            num += swz_xor<1>(num); den += swz_xor<1>(den); num += swz_xor<2>(num); den += swz_xor<2>(den); num += swz_xor<4>(num); den += swz_xor<4>(den);
            if (dg == 0) { const float hv = num / fmaxf(fabsf(den), __expf(-m)); HS[(tok0 + t) * 1024 + h * 256 + vs * 64 + v] = (bf16)(pg8::cvt_pk_bf16(hv, 0.f) & 0xffffu); }
        }
    }
}
typedef float f32x16 __attribute__((ext_vector_type(16)));
typedef short s16x8 __attribute__((ext_vector_type(8)));
constexpr int AT_KROW = 400, AT_VROW = 136, AT_KBYTES = 64 * AT_KROW, AT_VBYTES = 128 * AT_VROW, AT_STAGE = AT_KBYTES + AT_VBYTES;
__device__ __forceinline__ s16x8 pack_p8(const f32x16& p, int b0) {
    u32x4 w; w.x = pg8::cvt_pk_bf16(p[b0 + 0], p[b0 + 1]); w.y = pg8::cvt_pk_bf16(p[b0 + 2], p[b0 + 3]); w.z = pg8::cvt_pk_bf16(p[b0 + 4], p[b0 + 5]); w.w = pg8::cvt_pk_bf16(p[b0 + 6], p[b0 + 7]);
    return __builtin_bit_cast(s16x8, w);
}
__device__ __forceinline__ void mla_attn_unit(int b, int h, int qb, const bf16* QN, const bf16* QR, const bf16* KN, const bf16* KR, const bf16* VT, const float* COS, const float* SIN, bf16* O, LAS unsigned char* lds, int tid) {
    const int lane = tid & 63, wid = __builtin_amdgcn_readfirstlane(tid >> 6), r32 = lane & 31, hh = lane >> 5;
    const size_t tok0 = (size_t)b * SEQ;
    const size_t qrow = tok0 + (size_t)qb * 256 + 32 * wid + r32;
    const int NT = 4 * qb + 4;
    constexpr int AT_KSLOT = 24 * 1024, AT_VBASE = 3 * AT_KSLOT, AT_VSLOT = 16 * 1024;
    static_assert(AT_VBASE + 4 * AT_VSLOT <= RING_BYTES, "attention LDS map");
    const int r32s = (r32 & ~0xC) | ((r32 & 4) << 1) | ((r32 & 8) >> 1);
    const bf16* gkn = KN + (tok0 + r32s) * 1024 + h * 128 + 8 * hh;
    const bf16* gkr = KR + (tok0 + r32s) * 64 + 8 * hh;
    const bf16* gvt = VT + (size_t)(h * 128 + r32) * VT_LD + tok0 + 8 * hh;
    const bf16* p0 = gkn + 16 * wid;
    const bf16* p1 = (wid < 4) ? gkr + 16 * wid : gkn + (size_t)32 * 1024 + 16 * (wid - 4);
    const bf16* p2 = (wid < 4) ? gkn + (size_t)32 * 1024 + 16 * (wid + 4) : gkr + 32 * 64 + 16 * (wid - 4);
    const bf16* p3 = gvt + (size_t)(32 * (wid >> 2)) * VT_LD + 32 * ((wid >> 1) & 1) + 16 * (wid & 1);
    const bf16* p4 = p3 + (size_t)64 * VT_LD;
    const int st1 = (wid < 4) ? 64 * 64 : 64 * 1024, st2 = (wid < 4) ? 64 * 1024 : 64 * 64;
#define AT_ISSUE(t) do { const int t_ = (t); LAS unsigned char* d_ = lds + (t_ % 3) * AT_KSLOT + wid * 1024; LAS unsigned char* e_ = lds + AT_VBASE + (t_ & 3) * AT_VSLOT + wid * 1024; \
        __builtin_amdgcn_global_load_lds((const unsigned*)(p0 + (size_t)t_ * 65536), (LAS unsigned*)d_, 16, 0, 0); \
        __builtin_amdgcn_global_load_lds((const unsigned*)(p1 + (size_t)t_ * st1), (LAS unsigned*)(d_ + 8192), 16, 0, 0); \
        __builtin_amdgcn_global_load_lds((const unsigned*)(p2 + (size_t)t_ * st2), (LAS unsigned*)(d_ + 16384), 16, 0, 0); \
        __builtin_amdgcn_global_load_lds((const unsigned*)(p3 + (size_t)t_ * 64), (LAS unsigned*)e_, 16, 0, 0); \
        __builtin_amdgcn_global_load_lds((const unsigned*)(p4 + (size_t)t_ * 64), (LAS unsigned*)(e_ + 8192), 16, 0, 0); } while (0)
#define DSR128(dst, addr, off) asm volatile("ds_read_b128 %0, %1 offset:%2" : "=v"(dst) : "v"(addr), "n"(off))
#define LGKM_WAIT4(n, a, b, c, d) asm volatile("s_waitcnt lgkmcnt(" #n ")" : "+v"(a), "+v"(b), "+v"(c), "+v"(d))
#define AT_QKB(SX, addr_, o_) do { s16x8 fa0, fa1, fa2, fa3, fb0, fb1, fb2, fb3; \
        DSR128(fa0, addr_, (o_) + 0); DSR128(fa1, addr_, (o_) + 1024); DSR128(fa2, addr_, (o_) + 2048); DSR128(fa3, addr_, (o_) + 3072); \
        DSR128(fb0, addr_, (o_) + 4096); DSR128(fb1, addr_, (o_) + 5120); DSR128(fb2, addr_, (o_) + 6144); DSR128(fb3, addr_, (o_) + 7168); \
        LGKM_WAIT4(4, fa0, fa1, fa2, fa3); \
        SX = __builtin_amdgcn_mfma_f32_32x32x16_bf16(fa0, qf[0], SX, 0, 0, 0); SX = __builtin_amdgcn_mfma_f32_32x32x16_bf16(fa1, qf[1], SX, 0, 0, 0); \
        SX = __builtin_amdgcn_mfma_f32_32x32x16_bf16(fa2, qf[2], SX, 0, 0, 0); SX = __builtin_amdgcn_mfma_f32_32x32x16_bf16(fa3, qf[3], SX, 0, 0, 0); \
        s16x8 fc0, fc1, fc2, fc3; \
        DSR128(fc0, addr_, (o_) + 8192); DSR128(fc1, addr_, (o_) + 9216); DSR128(fc2, addr_, (o_) + 10240); DSR128(fc3, addr_, (o_) + 11264); \
        LGKM_WAIT4(4, fb0, fb1, fb2, fb3); \
        SX = __builtin_amdgcn_mfma_f32_32x32x16_bf16(fb0, qf[4], SX, 0, 0, 0); SX = __builtin_amdgcn_mfma_f32_32x32x16_bf16(fb1, qf[5], SX, 0, 0, 0); \
        SX = __builtin_amdgcn_mfma_f32_32x32x16_bf16(fb2, qf[6], SX, 0, 0, 0); SX = __builtin_amdgcn_mfma_f32_32x32x16_bf16(fb3, qf[7], SX, 0, 0, 0); \
        LGKM_WAIT4(0, fc0, fc1, fc2, fc3); \
        SX = __builtin_amdgcn_mfma_f32_32x32x16_bf16(fc0, qf[8], SX, 0, 0, 0); SX = __builtin_amdgcn_mfma_f32_32x32x16_bf16(fc1, qf[9], SX, 0, 0, 0); \
        SX = __builtin_amdgcn_mfma_f32_32x32x16_bf16(fc2, qf[10], SX, 0, 0, 0); SX = __builtin_amdgcn_mfma_f32_32x32x16_bf16(fc3, qf[11], SX, 0, 0, 0); } while (0)
#define AT_PVB(PA, PB, kb_) do { \
        { s16x8 v0, v1, v2, v3; DSR128(v0, va, (0 + 2 * (kb_)) * 1024); DSR128(v1, va, (4 + 2 * (kb_)) * 1024); DSR128(v2, va, (8 + 2 * (kb_)) * 1024); DSR128(v3, va, (12 + 2 * (kb_)) * 1024); \
            LGKM_WAIT4(0, v0, v1, v2, v3); \
            o[0] = __builtin_amdgcn_mfma_f32_32x32x16_bf16(v0, PA, o[0], 0, 0, 0); o[1] = __builtin_amdgcn_mfma_f32_32x32x16_bf16(v1, PA, o[1], 0, 0, 0); \
            o[2] = __builtin_amdgcn_mfma_f32_32x32x16_bf16(v2, PA, o[2], 0, 0, 0); o[3] = __builtin_amdgcn_mfma_f32_32x32x16_bf16(v3, PA, o[3], 0, 0, 0); } \
        { s16x8 v0, v1, v2, v3; DSR128(v0, va, (1 + 2 * (kb_)) * 1024); DSR128(v1, va, (5 + 2 * (kb_)) * 1024); DSR128(v2, va, (9 + 2 * (kb_)) * 1024); DSR128(v3, va, (13 + 2 * (kb_)) * 1024); \
            LGKM_WAIT4(0, v0, v1, v2, v3); \
            o[0] = __builtin_amdgcn_mfma_f32_32x32x16_bf16(v0, PB, o[0], 0, 0, 0); o[1] = __builtin_amdgcn_mfma_f32_32x32x16_bf16(v1, PB, o[1], 0, 0, 0); \
            o[2] = __builtin_amdgcn_mfma_f32_32x32x16_bf16(v2, PB, o[2], 0, 0, 0); o[3] = __builtin_amdgcn_mfma_f32_32x32x16_bf16(v3, PB, o[3], 0, 0, 0); } } while (0)
    f32x16 o[4];
#pragma unroll
    for (int d = 0; d < 4; ++d)
#pragma unroll
        for (int r = 0; r < 16; ++r) o[d][r] = 0.f;
    float m_run = -1e30f, l_run = 0.f;
    f32x16 s0, s1;
    AT_ISSUE(0); AT_ISSUE(1);
    s16x8 qf[12];
#pragma unroll
    for (int s = 0; s < 8; ++s) qf[s] = *(const s16x8*)(QN + qrow * 1024 + h * 128 + 16 * s + 8 * hh);
#pragma unroll
    for (int s = 0; s < 4; ++s) qf[8 + s] = *(const s16x8*)(QR + qrow * 512 + h * 64 + 16 * s + 8 * hh);
#pragma unroll
    for (int s = 0; s < 2; ++s) {
        const float* cp = COS + qrow * 32 + 16 * s + 8 * hh; const float* sp = SIN + qrow * 32 + 16 * s + 8 * hh;
        const f32x4 c0 = *(const f32x4*)cp, c1 = *(const f32x4*)(cp + 4), s0 = *(const f32x4*)sp, s1 = *(const f32x4*)(sp + 4);
        const u32x4 xa = __builtin_bit_cast(u32x4, qf[8 + s]), xb = __builtin_bit_cast(u32x4, qf[10 + s]); u32x4 oa, ob;
#pragma unroll
        for (int w = 0; w < 4; ++w) { const float cl = w < 2 ? c0[2 * w] : c1[2 * w - 4], ch = w < 2 ? c0[2 * w + 1] : c1[2 * w - 3], sl = w < 2 ? s0[2 * w] : s1[2 * w - 4], sh = w < 2 ? s0[2 * w + 1] : s1[2 * w - 3];
            const float x1l = bflo(xa[w]), x1h = bfhi(xa[w]), x2l = bflo(xb[w]), x2h = bfhi(xb[w]);
            oa[w] = pg8::cvt_pk_bf16(x1l * cl - x2l * sl, x1h * ch - x2h * sh); ob[w] = pg8::cvt_pk_bf16(x2l * cl + x1l * sl, x2h * ch + x1h * sh); }
        qf[8 + s] = __builtin_bit_cast(s16x8, oa); qf[10 + s] = __builtin_bit_cast(s16x8, ob); }
    asm volatile("s_waitcnt vmcnt(0)" ::: "memory");
    const bool late = wid >= 4; bool pact0 = false, pact1 = false;
    s16x8 pa0 = {0, 0, 0, 0, 0, 0, 0, 0}, pb0 = pa0, pa1 = pa0, pb1 = pa0;
    for (int t = 0; t < NT; ++t) {
        if (t + 1 < NT) asm volatile("s_waitcnt vmcnt(5)" ::: "memory"); else asm volatile("s_waitcnt vmcnt(0)" ::: "memory");
        asm volatile("s_waitcnt lgkmcnt(0)\n\ts_barrier" ::: "memory");
        if (t + 2 < NT) AT_ISSUE(t + 2);
        int sa = (t % 3) * AT_KSLOT + lane * 16; asm volatile("" : "+v"(sa));
        if (late && t > 0) { int va = AT_VBASE + ((t - 1) & 3) * AT_VSLOT + lane * 16; asm volatile("" : "+v"(va)); if (pact0) AT_PVB(pa0, pb0, 0); if (pact1) AT_PVB(pa1, pb1, 1); }
        const int jj = t - 4 * qb;
        const bool act0 = (jj < 0) || (2 * jj <= wid), act1 = (jj < 0) || (2 * jj + 1 <= wid);
#pragma unroll
        for (int r = 0; r < 16; ++r) { s0[r] = 0.f; s1[r] = 0.f; }
        if (act0) AT_QKB(s0, sa, 0);
        if (act1) AT_QKB(s1, sa, 12 * 1024);
        const float NEG = -__builtin_inff();
        if (jj >= 0) {
            const int d0 = 32 * wid + r32 - 64 * jj - 8 * hh;
#pragma unroll
            for (int r = 0; r < 16; ++r) { const int c = (r & 3) + 4 * ((r >> 2) & 1) + 16 * (r >> 3); if (c > d0) s0[r] = NEG; if (c + 32 > d0) s1[r] = NEG; }
        }
        float mx = fmaxf(s0[0], s1[0]);
#pragma unroll
        for (int r = 1; r < 16; ++r) mx = fmaxf(mx, fmaxf(s0[r], s1[r]));
        mx = xor32(mx, true);
        if (__builtin_amdgcn_ballot_w64(mx > m_run + 8.f) != 0ull) {
            const float m_new = fmaxf(m_run, mx), alpha = __builtin_amdgcn_exp2f(m_run - m_new); m_run = m_new; l_run *= alpha;
#pragma unroll
            for (int d = 0; d < 4; ++d)
#pragma unroll
                for (int r = 0; r < 16; ++r) o[d][r] *= alpha;
        }
        float ps = 0.f;
#pragma unroll
        for (int r = 0; r < 16; ++r) { s0[r] = __builtin_amdgcn_exp2f(s0[r] - m_run); s1[r] = __builtin_amdgcn_exp2f(s1[r] - m_run); ps += s0[r] + s1[r]; }
        l_run += ps;
        pa0 = pack_p8(s0, 0); pb0 = pack_p8(s0, 8); pa1 = pack_p8(s1, 0); pb1 = pack_p8(s1, 8);
        if (!late) { int va = AT_VBASE + (t & 3) * AT_VSLOT + lane * 16; asm volatile("" : "+v"(va)); if (act0) AT_PVB(pa0, pb0, 0); if (act1) AT_PVB(pa1, pb1, 1); }
        else { pact0 = act0; pact1 = act1; }
    }
    if (late) { int va = AT_VBASE + ((NT - 1) & 3) * AT_VSLOT + lane * 16; asm volatile("" : "+v"(va)); if (pact0) AT_PVB(pa0, pb0, 0); if (pact1) AT_PVB(pa1, pb1, 1); }
    asm volatile("s_waitcnt lgkmcnt(0)\n\ts_barrier" ::: "memory");
    const float inv = 1.f / xor32(l_run, false);
    LAS unsigned char* st = lds + wid * (32 * 144);
    bf16* obase = O + (tok0 + (size_t)qb * 256 + 32 * wid) * 1024 + h * 128;
#pragma unroll
    for (int half = 0; half < 2; ++half) {
#pragma unroll
        for (int dd = 0; dd < 2; ++dd)
#pragma unroll
            for (int g = 0; g < 4; ++g) { const int d = 2 * half + dd; u32x2 w; w.x = pg8::cvt_pk_bf16(o[d][4 * g] * inv, o[d][4 * g + 1] * inv); w.y = pg8::cvt_pk_bf16(o[d][4 * g + 2] * inv, o[d][4 * g + 3] * inv);
                *(LAS u32x2*)(st + r32 * 144 + (32 * dd + 8 * g + 4 * hh) * 2) = w; }
        asm volatile("s_waitcnt lgkmcnt(0)" ::: "memory");
#pragma unroll
        for (int i = 0; i < 4; ++i) { const int id = i * 64 + lane, row = id >> 3, ch = id & 7; const u32x4 v = *(const LAS u32x4*)(st + row * 144 + ch * 16);
            *(u32x4*)(obase + (size_t)row * 1024 + 64 * half + ch * 8) = v; }
        asm volatile("s_waitcnt lgkmcnt(0)" ::: "memory");
    }
    asm volatile("s_waitcnt vmcnt(0) lgkmcnt(0)\n\ts_barrier" ::: "memory");
#undef AT_ISSUE
#undef AT_QKB
#undef AT_PVB
#undef DSR128
#undef LGKM_WAIT4
}
constexpr int XA_KROW = 528, XA_KBYTES = 64 * XA_KROW, XA_VROW = 136, XA_STAGE = XA_KBYTES;
__device__ __forceinline__ void mem_attn_unit(int pm, int h, const bf16* QM, const bf16* KMl, const bf16* VMTl, bf16* O, LAS unsigned char* lds, int tid) {
    const int lane = tid & 63, wid = __builtin_amdgcn_readfirstlane(tid >> 6), r32 = lane & 31, hh = lane >> 5;
    const int b = pm >> 3;
    const size_t qrow = (size_t)pm * 256 + 32 * wid + r32;
    const bf16* gk = KMl + ((size_t)b * NMEM + (tid >> 5)) * 1024 + h * 256 + (tid & 31) * 8;
    const bf16* gv = VMTl + (size_t)(h * 256 + (tid >> 3)) * VMT_LD + (size_t)b * NMEM + (tid & 7) * 8;
    const int lk = (tid >> 5) * XA_KROW + (tid & 31) * 16, lv = (tid >> 3) * XA_VROW + (tid & 7) * 16;
    u32x4 sa0, sa1, sa2, sa3, sb0, sb1, sb2, sb3;
#define XA_LOAD(P, st) do { if ((st) < 4) { const bf16* p_ = gk + (size_t)(64 * (st)) * 1024; P##0 = *(const u32x4*)p_; P##1 = *(const u32x4*)(p_ + 16 * 1024); P##2 = *(const u32x4*)(p_ + 32 * 1024); P##3 = *(const u32x4*)(p_ + 48 * 1024); } \
                         else { const bf16* p_ = gv + (size_t)(128 * (((st) - 4) >> 2)) * VMT_LD + 64 * (((st) - 4) & 3); P##0 = *(const u32x4*)p_; P##1 = *(const u32x4*)(p_ + (size_t)64 * VMT_LD); } } while (0)
#define XA_WRITE(P, st, bo) do { if ((st) < 4) { *(LAS u32x4*)(lds + (bo) + lk) = P##0; *(LAS u32x4*)(lds + (bo) + lk + 16 * XA_KROW) = P##1; *(LAS u32x4*)(lds + (bo) + lk + 32 * XA_KROW) = P##2; *(LAS u32x4*)(lds + (bo) + lk + 48 * XA_KROW) = P##3; } \
                              else { *(LAS u32x2*)(lds + (bo) + lv) = (u32x2){(P##0).x, (P##0).y}; *(LAS u32x2*)(lds + (bo) + lv + 8) = (u32x2){(P##0).z, (P##0).w}; \
                                     *(LAS u32x2*)(lds + (bo) + lv + 64 * XA_VROW) = (u32x2){(P##1).x, (P##1).y}; *(LAS u32x2*)(lds + (bo) + lv + 64 * XA_VROW + 8) = (u32x2){(P##1).z, (P##1).w}; } } while (0)
    f32x16 S[8]; s16x8 P[8][2]; f32x16 o[4]; float linv = 0.f;
    const int ka = r32 * XA_KROW + 16 * hh, va = r32 * XA_VROW + 8 * hh;
    XA_LOAD(sa, 0); XA_LOAD(sb, 1);
    s16x8 qf[16];
#pragma unroll
    for (int s = 0; s < 16; ++s) qf[s] = *(const s16x8*)(QM + qrow * 1024 + h * 256 + 16 * s + 8 * hh);
    XA_WRITE(sa, 0, 0); __syncthreads();
#pragma unroll
    for (int st = 0; st < 12; ++st) {
        const int bo = (st & 1) * XA_STAGE;
        if (st + 2 < 12) { if ((st & 1) == 0) XA_LOAD(sa, st + 2); else XA_LOAD(sb, st + 2); }
        if (st < 4) {
#pragma unroll
            for (int kb = 0; kb < 2; ++kb) { f32x16 acc;
#pragma unroll
                for (int r = 0; r < 16; ++r) acc[r] = 0.f;
#pragma unroll
                for (int s = 0; s < 16; ++s) { const s16x8 a = *(const LAS s16x8*)(lds + bo + ka + 32 * kb * XA_KROW + 32 * s); acc = __builtin_amdgcn_mfma_f32_32x32x16_bf16(a, qf[s], acc, 0, 0, 0); }
                S[2 * st + kb] = acc; }
            if (st == 3) {
                float mx = S[0][0];
#pragma unroll
                for (int i = 0; i < 8; ++i)
#pragma unroll
                    for (int r = 0; r < 16; ++r) mx = fmaxf(mx, S[i][r]);
                mx = xor32(mx, true);
                float ps = 0.f;
#pragma unroll
                for (int i = 0; i < 8; ++i) {
#pragma unroll
                    for (int r = 0; r < 16; ++r) { S[i][r] = __builtin_amdgcn_exp2f(S[i][r] - mx); ps += S[i][r]; }
                    P[i][0] = pack_p8(S[i], 0); P[i][1] = pack_p8(S[i], 8); }
                linv = 1.f / xor32(ps, false);
            }
        } else {
            const int t = (st - 4) & 3, dvh = (st - 4) >> 2;
            if (t == 0) {
#pragma unroll
                for (int d = 0; d < 4; ++d)
#pragma unroll
                    for (int r = 0; r < 16; ++r) o[d][r] = 0.f; }
#pragma unroll
            for (int kb = 0; kb < 2; ++kb)
#pragma unroll
                for (int s2 = 0; s2 < 2; ++s2)
#pragma unroll
                    for (int d = 0; d < 4; ++d) { const u32x2 lo = *(const LAS u32x2*)(lds + bo + va + 32 * d * XA_VROW + 64 * kb + 32 * s2), hi = *(const LAS u32x2*)(lds + bo + va + 32 * d * XA_VROW + 64 * kb + 32 * s2 + 16);
                        const u32x4 aw = (u32x4){lo.x, lo.y, hi.x, hi.y}; o[d] = __builtin_amdgcn_mfma_f32_32x32x16_bf16(__builtin_bit_cast(s16x8, aw), P[2 * t + kb][s2], o[d], 0, 0, 0); }
            if (t == 3) {
                int ln2 = lane; asm volatile("" : "+v"(ln2)); const int r32 = ln2 & 31, hh = ln2 >> 5;
                LAS unsigned char* stg = lds + 2 * XA_STAGE + wid * (32 * 272); bf16* obase = O + ((size_t)pm * 256 + 32 * wid) * 1024 + h * 256 + 128 * dvh;
#pragma unroll
                for (int d = 0; d < 4; ++d)
#pragma unroll
                    for (int g = 0; g < 4; ++g) { u32x2 w; w.x = pg8::cvt_pk_bf16(o[d][4 * g] * linv, o[d][4 * g + 1] * linv); w.y = pg8::cvt_pk_bf16(o[d][4 * g + 2] * linv, o[d][4 * g + 3] * linv);
                        *(LAS u32x2*)(stg + r32 * 272 + (32 * d + 8 * g + 4 * hh) * 2) = w; }
                asm volatile("s_waitcnt lgkmcnt(0)" ::: "memory");
#pragma unroll
                for (int i = 0; i < 8; ++i) { const int id = i * 64 + lane, row = id >> 4, ch = id & 15; const u32x4 v = *(const LAS u32x4*)(stg + row * 272 + ch * 16);
                    *(u32x4*)(obase + (size_t)row * 1024 + ch * 8) = v; }
                asm volatile("s_waitcnt lgkmcnt(0)" ::: "memory"); }
        }
        if (st + 1 < 12) { if ((st & 1) == 0) XA_WRITE(sb, st + 1, XA_STAGE); else XA_WRITE(sa, st + 1, 0); }
        __syncthreads();
    }
#undef XA_LOAD
#undef XA_WRITE
}
constexpr int SC_QROW = 272, SC_TROW = 144;
constexpr int SC_QT = 0, SC_KT = SC_QT + 64 * SC_QROW, SC_VTW = SC_KT + 64 * SC_QROW, SC_VT = SC_VTW + 96 * SC_TROW, SC_P = SC_VT + 96 * SC_TROW, SC_CB = SC_P + 64 * SC_TROW,
              SC_CBSZ = 96 * SC_QROW, SC_GA = SC_CB + 2 * SC_CBSZ, SC_GASZ = 1536, SC_DEN = SC_GA + 2 * SC_GASZ, SC_HS = SC_DEN + 256, SC_END = SC_HS + 64 * 128;
static_assert(SC_END <= RING_BYTES, "scan LDS map");
template <int CTRL> __device__ __forceinline__ float dpp_f(float oldv, float v) { return __int_as_float(__builtin_amdgcn_update_dpp(__float_as_int(oldv), __float_as_int(v), CTRL, 0xf, 0xf, false)); }
__device__ __forceinline__ float rdlane(float v, int l) { return __int_as_float(__builtin_amdgcn_readlane(__float_as_int(v), l)); }
__device__ __forceinline__ float scan_gates(const float li, const float fg, float m, LAS float* ga, int lane) {
    const float lf = log_sigmoid(fg);
    float v = lf;
    v += dpp_f<0x111>(0.f, v); v += dpp_f<0x112>(0.f, v); v += dpp_f<0x114>(0.f, v); v += dpp_f<0x118>(0.f, v);
    { const float t0 = rdlane(v, 15), t1 = rdlane(v, 31), t2 = rdlane(v, 47); const int row = lane >> 4; v += (row >= 1 ? t0 : 0.f) + (row >= 2 ? t1 : 0.f) + (row >= 3 ? t2 : 0.f); }
    const float b = v, a = li - b;
    const float NEG = -__builtin_inff();
    float p = a;
    p = fmaxf(p, dpp_f<0x111>(NEG, p)); p = fmaxf(p, dpp_f<0x112>(NEG, p)); p = fmaxf(p, dpp_f<0x114>(NEG, p)); p = fmaxf(p, dpp_f<0x118>(NEG, p));
    { const float t0 = rdlane(p, 15), t1 = rdlane(p, 31), t2 = rdlane(p, 47); const int row = lane >> 4;
      float o = NEG; if (row >= 1) o = t0; if (row >= 2) o = fmaxf(o, t1); if (row >= 3) o = fmaxf(o, t2); p = fmaxf(p, o); }
    const float mt = b + fmaxf(m, p);
    const float b_last = rdlane(b, 63), m_new = rdlane(mt, 63);
    ga[lane] = __expf(b_last - m_new + a); ga[64 + lane] = a; ga[128 + lane] = b - mt; ga[192 + lane] = __expf(b + m - mt); ga[256 + lane] = __expf(-mt);
    if (lane == 0) ga[320] = __expf(b_last + m - m_new);
    return m_new;
}
__device__ __forceinline__ void mlstm_scan_unit(int unit, const bf16* QK, const bf16* KVT, const float* GATES, bf16* HS, LAS unsigned char* lds, int tid) {
    const int b = unit >> 4, h = (unit >> 2) & 3, vs = unit & 3;
    const int lane = tid & 63, wid = __builtin_amdgcn_readfirstlane(tid >> 6), r32 = lane & 31, hh = lane >> 5;
    const size_t tokb = (size_t)b * SEQ;
    const __amdgpu_buffer_rsrc_t rQ = __builtin_amdgcn_make_buffer_rsrc((void*)(QK + tokb * 1024 + h * 128), 0, 0x7fffffff, 0x00020000);
    const __amdgpu_buffer_rsrc_t rV = __builtin_amdgcn_make_buffer_rsrc((void*)(KVT + (size_t)(h * 256 + vs * 64) * KVT_LD + tokb), 0, 0x7fffffff, 0x00020000);
    const int vq = ((tid >> 4) * 1024 + (tid & 15) * 8) * 2, vt = (int)(((size_t)(tid >> 3) * KVT_LD + (tid & 7) * 8) * 2);
    const int lq = (tid >> 4) * SC_QROW + (tid & 15) * 16, lt = (tid >> 3) * SC_TROW + (tid & 7) * 16;
    u32x4 aq0, aq1, ak0, ak1, av0, bq0, bq1, bk0, bk1, bv0;
#define SC_BL(r_, v_, s_) __builtin_bit_cast(u32x4, __builtin_amdgcn_raw_buffer_load_b128(r_, v_, s_, 0))
#define SC_LOAD(P, c) do { const int sq_ = (c) * (64 * 1024 * 2), st_ = (c) * 128; P##q0 = SC_BL(rQ, vq, sq_); P##q1 = SC_BL(rQ, vq, sq_ + 32 * 1024 * 2); P##k0 = SC_BL(rQ, vq, sq_ + 1024); P##k1 = SC_BL(rQ, vq, sq_ + 32 * 1024 * 2 + 1024); \
        P##v0 = SC_BL(rV, vt, st_); } while (0)
#define SC_SCALE8(V_, wkp) do { const f32x4 a_ = *(const LAS f32x4*)(wkp), b_ = *(const LAS f32x4*)((wkp) + 4); u32x4 n_; \
        n_.x = pg8::cvt_pk_bf16(bflo(V_.x) * a_[0], bfhi(V_.x) * a_[1]); n_.y = pg8::cvt_pk_bf16(bflo(V_.y) * a_[2], bfhi(V_.y) * a_[3]); n_.z = pg8::cvt_pk_bf16(bflo(V_.z) * b_[0], bfhi(V_.z) * b_[1]); n_.w = pg8::cvt_pk_bf16(bflo(V_.w) * b_[2], bfhi(V_.w) * b_[3]); V_ = n_; } while (0)
#define SC_WRITE(P, gab) do { *(LAS u32x4*)(lds + SC_QT + lq) = P##q0; *(LAS u32x4*)(lds + SC_QT + lq + 32 * SC_QROW) = P##q1; *(LAS u32x4*)(lds + SC_KT + lq) = P##k0; *(LAS u32x4*)(lds + SC_KT + lq + 32 * SC_QROW) = P##k1; \
        { const LAS float* wkp_ = (const LAS float*)(lds + SC_GA + (gab) * SC_GASZ) + (tid & 7) * 8; u32x4 vw_ = P##v0; SC_SCALE8(vw_, wkp_); *(LAS u32x4*)(lds + SC_VTW + lt) = vw_; \
          if (tid < 8) { const f32x4 a_ = *(const LAS f32x4*)(wkp_), b_ = *(const LAS f32x4*)(wkp_ + 4); u32x4 n_; n_.x = pg8::cvt_pk_bf16(a_[0], a_[1]); n_.y = pg8::cvt_pk_bf16(a_[2], a_[3]); n_.z = pg8::cvt_pk_bf16(b_[0], b_[1]); n_.w = pg8::cvt_pk_bf16(b_[2], b_[3]); \
              *(LAS u32x4*)(lds + SC_VTW + 64 * SC_TROW + tid * 16) = n_; } } \
        *(LAS u32x4*)(lds + SC_VT + lt) = P##v0; } while (0)
    SC_LOAD(a, 0);
    for (int i = tid; i < 32 * SC_TROW / 4; i += NWAVES * 64) ((LAS unsigned*)(lds + SC_VT + 64 * SC_TROW))[i] = (i < SC_TROW / 4) ? 0x3f803f80u : 0u;
    for (int i = tid; i < SC_CBSZ / 4; i += NWAVES * 64) ((LAS unsigned*)(lds + SC_CB))[i] = 0u;
    for (int i = tid; i < 32 * SC_TROW / 4; i += NWAVES * 64) ((LAS unsigned*)(lds + SC_VTW + 64 * SC_TROW))[i] = 0u;
    float m_run = 0.f, gli = 0.f, gfg = 0.f;
    if (wid == 7) { const float l0 = GATES[(tokb + lane) * 8 + h], f0 = GATES[(tokb + lane) * 8 + 4 + h]; gli = GATES[(tokb + 64 + lane) * 8 + h]; gfg = GATES[(tokb + 64 + lane) * 8 + 4 + h];
        m_run = scan_gates(l0, f0, 0.f, (LAS float*)(lds + SC_GA), lane); }
    __syncthreads();
    SC_WRITE(a, 0); SC_LOAD(b, 1);
    __syncthreads();
    f32x16 cacc[2], acc;
#pragma unroll
    for (int r = 0; r < 16; ++r) { cacc[0][r] = 0.f; cacc[1][r] = 0.f; acc[r] = 0.f; }
    const int tb = wid & 1, vb = wid >> 1;
    typedef short s16x4 __attribute__((ext_vector_type(4)));
    int ktb = SC_KT + (8 * hh + ((lane >> 2) & 3)) * SC_QROW + (64 * tb + 16 * ((lane >> 4) & 1) + 4 * (lane & 3)) * 2; asm volatile("" : "+v"(ktb));
#define SC_TR(dst, addr, off) asm volatile("ds_read_b64_tr_b16 %0, %1 offset:%2" : "=&v"(dst) : "v"(addr), "n"(off) : "memory")
    for (int c2 = 0; c2 < SEQ / 64; c2 += 2) {
#pragma unroll
      for (int par = 0; par < 2; ++par) { const int c = c2 + par;
        const size_t tok0 = tokb + (size_t)c * 64;
        const int gab = par; const LAS float* ga = (const LAS float*)(lds + SC_GA + gab * SC_GASZ);
        const int cbo = SC_CB + gab * SC_CBSZ, cbn = SC_CB + (gab ^ 1) * SC_CBSZ;
        if (c + 2 < SEQ / 64) { if (par == 0) SC_LOAD(a, c + 2); else SC_LOAD(b, c + 2); }
        if (c + 1 < SEQ / 64 && wid == 7) { m_run = scan_gates(gli, gfg, m_run, (LAS float*)(lds + SC_GA + (gab ^ 1) * SC_GASZ), lane);
            if (c + 2 < SEQ / 64) { gli = GATES[(tok0 + 128 + lane) * 8 + h]; gfg = GATES[(tok0 + 128 + lane) * 8 + 4 + h]; } }
        if (wid < 6) {
#pragma unroll
            for (int r = 0; r < 16; ++r) acc[r] = 0.f;
#pragma unroll
            for (int s = 0; s < 8; ++s) { const s16x8 a = *(const LAS s16x8*)(lds + SC_QT + (32 * tb + r32) * SC_QROW + 32 * s + 16 * hh), bb = *(const LAS s16x8*)(lds + cbo + (32 * vb + r32) * SC_QROW + 32 * s + 16 * hh);
                acc = __builtin_amdgcn_mfma_f32_32x32x16_bf16(a, bb, acc, 0, 0, 0); }
#pragma unroll
            for (int r = 0; r < 16; ++r) acc[r] *= ga[192 + 32 * tb + (r & 3) + 8 * (r >> 2) + 4 * hh];
            const float decay = ga[320];
#pragma unroll
            for (int i = 0; i < 2; ++i) { const int db = 2 * tb + i; (void)db;
#pragma unroll
                for (int r = 0; r < 16; ++r) cacc[i][r] *= decay;
                s16x4 kl0, kl1, kl2, kl3, kh0, kh1, kh2, kh3; int kta = ktb + i * 64; asm volatile("" : "+v"(kta));
                SC_TR(kl0, kta, 0 * 16 * SC_QROW); SC_TR(kh0, kta, 0 * 16 * SC_QROW + 4 * SC_QROW); SC_TR(kl1, kta, 1 * 16 * SC_QROW); SC_TR(kh1, kta, 1 * 16 * SC_QROW + 4 * SC_QROW);
                SC_TR(kl2, kta, 2 * 16 * SC_QROW); SC_TR(kh2, kta, 2 * 16 * SC_QROW + 4 * SC_QROW); SC_TR(kl3, kta, 3 * 16 * SC_QROW); SC_TR(kh3, kta, 3 * 16 * SC_QROW + 4 * SC_QROW);
                asm volatile("s_waitcnt lgkmcnt(0)" : "+v"(kl0), "+v"(kh0), "+v"(kl1), "+v"(kh1), "+v"(kl2), "+v"(kh2), "+v"(kl3), "+v"(kh3));
#define SC_CAT(lo_, hi_) __builtin_shufflevector(lo_, hi_, 0, 1, 2, 3, 4, 5, 6, 7)
                { const s16x8 bb = *(const LAS s16x8*)(lds + SC_VTW + (32 * vb + r32) * SC_TROW + 32 * 0 + 16 * hh); cacc[i] = __builtin_amdgcn_mfma_f32_32x32x16_bf16(SC_CAT(kl0, kh0), bb, cacc[i], 0, 0, 0); }
                { const s16x8 bb = *(const LAS s16x8*)(lds + SC_VTW + (32 * vb + r32) * SC_TROW + 32 * 1 + 16 * hh); cacc[i] = __builtin_amdgcn_mfma_f32_32x32x16_bf16(SC_CAT(kl1, kh1), bb, cacc[i], 0, 0, 0); }
                { const s16x8 bb = *(const LAS s16x8*)(lds + SC_VTW + (32 * vb + r32) * SC_TROW + 32 * 2 + 16 * hh); cacc[i] = __builtin_amdgcn_mfma_f32_32x32x16_bf16(SC_CAT(kl2, kh2), bb, cacc[i], 0, 0, 0); }
                { const s16x8 bb = *(const LAS s16x8*)(lds + SC_VTW + (32 * vb + r32) * SC_TROW + 32 * 3 + 16 * hh); cacc[i] = __builtin_amdgcn_mfma_f32_32x32x16_bf16(SC_CAT(kl3, kh3), bb, cacc[i], 0, 0, 0); }
#undef SC_CAT
#pragma unroll
                for (int g = 0; g < 4; ++g) { u32x2 w; w.x = pg8::cvt_pk_bf16(cacc[i][4 * g], cacc[i][4 * g + 1]); w.y = pg8::cvt_pk_bf16(cacc[i][4 * g + 2], cacc[i][4 * g + 3]);
                    *(LAS u32x2*)(lds + cbn + (32 * vb + r32) * SC_QROW + (32 * db + 8 * g + 4 * hh) * 2) = w; } }
        } else {
#pragma unroll
            for (int i = 0; i < 2; ++i) { if (wid == 7 && i == 1) break;
                const int sb = (wid == 6) ? i : 0, tb2 = (wid == 6) ? i : 1;
                f32x16 st;
#pragma unroll
                for (int r = 0; r < 16; ++r) st[r] = 0.f;
#pragma unroll
                for (int s = 0; s < 8; ++s) { const s16x8 a = *(const LAS s16x8*)(lds + SC_KT + (32 * sb + r32) * SC_QROW + 32 * s + 16 * hh), bb = *(const LAS s16x8*)(lds + SC_QT + (32 * tb2 + r32) * SC_QROW + 32 * s + 16 * hh);
                    st = __builtin_amdgcn_mfma_f32_32x32x16_bf16(a, bb, st, 0, 0, 0); }
                const float bmt = ga[128 + 32 * tb2 + r32];
#pragma unroll
                for (int r = 0; r < 16; ++r) { const int cr = (r & 3) + 8 * (r >> 2) + 4 * hh; const float w = __expf(bmt + ga[64 + 32 * sb + cr]);
                    st[r] = (sb < tb2 || cr <= r32) ? st[r] * w : 0.f; }
#pragma unroll
                for (int g = 0; g < 4; ++g) { u32x2 w; w.x = pg8::cvt_pk_bf16(st[4 * g], st[4 * g + 1]); w.y = pg8::cvt_pk_bf16(st[4 * g + 2], st[4 * g + 3]);
                    *(LAS u32x2*)(lds + SC_P + (32 * tb2 + r32) * SC_TROW + (32 * sb + 8 * g + 4 * hh) * 2) = w; } }
        }
        __syncthreads();
        if (wid < 6) {
#pragma unroll
            for (int sb = 0; sb < 2; ++sb) { if (sb > tb) break;
#pragma unroll
                for (int s = 0; s < 2; ++s) { const s16x8 a = *(const LAS s16x8*)(lds + SC_P + (32 * tb + r32) * SC_TROW + 64 * sb + 32 * s + 16 * hh), bb = *(const LAS s16x8*)(lds + SC_VT + (32 * vb + r32) * SC_TROW + 64 * sb + 32 * s + 16 * hh);
                    acc = __builtin_amdgcn_mfma_f32_32x32x16_bf16(a, bb, acc, 0, 0, 0); } }
            if (vb == 2 && r32 == 0) {
#pragma unroll
                for (int r = 0; r < 16; ++r) ((LAS float*)(lds + SC_DEN))[32 * tb + (r & 3) + 8 * (r >> 2) + 4 * hh] = acc[r]; }
        }
        __syncthreads();
        if (wid < 4) {
#pragma unroll
            for (int r = 0; r < 16; ++r) { const int t = 32 * tb + (r & 3) + 8 * (r >> 2) + 4 * hh; const float dn = fmaxf(fabsf(((const LAS float*)(lds + SC_DEN))[t]), ga[256 + t]);
                *(LAS bf16*)(lds + SC_HS + t * 128 + (32 * vb + r32) * 2) = (bf16)(pg8::cvt_pk_bf16(acc[r] * __builtin_amdgcn_rcpf(dn), 0.f) & 0xffffu); }
        }
        if (c + 1 < SEQ / 64) { if (par == 0) SC_WRITE(b, 1); else SC_WRITE(a, 0); }
        __syncthreads();
        *(u32x4*)(HS + (tok0 + (tid >> 3)) * 1024 + h * 256 + vs * 64 + (tid & 7) * 8) = *(const LAS u32x4*)(lds + SC_HS + (tid >> 3) * 128 + (tid & 7) * 16);
      }
    }
#undef SC_LOAD
#undef SC_BL
#undef SC_SCALE8
#undef SC_WRITE
#undef SC_TR
}
#ifndef MK_ONE_LAUNCH
#define MK_ONE_LAUNCH 1
#endif
constexpr int NPH_L = 13, NPHASES = 2 + DEPTH * NPH_L;
struct Args { const void* in[25]; float* out; unsigned char* ws; int lo, hi; };

template <int SITE  >
__global__ void __launch_bounds__(NWAVES * 64, 2) fwd(Args args) {
    extern __shared__ __attribute__((aligned(16))) unsigned char lds_raw[];
    LAS unsigned char* lds = (LAS unsigned char*)lds_raw;
    const int G = gridDim.x, bx = blockIdx.x, NGW = G * NWAVES;
    const int wave_s = __builtin_amdgcn_readfirstlane((int)(threadIdx.x >> 6));
#define PH_REGS int tid = wave_s * 64 + pg8::lane_id(); asm volatile("" : "+v"(tid)); const int lane = tid & 63, wave = __builtin_amdgcn_readfirstlane(tid >> 6), gw = opq_s(bx) * NWAVES + wave; (void)lane; (void)gw;
    typedef const void* cvp_t; const __attribute__((address_space(4))) cvp_t* kargs = (const __attribute__((address_space(4))) cvp_t*)__builtin_amdgcn_kernarg_segment_ptr();
    gu32* ctl = (gu32*)((GAS unsigned char*)kargs[26] + WS_CTL);
    static_assert(sizeof(Args) == 27 * 8 + 8, "Args layout: 25 inputs, out, ws at 8-byte slots 0..26, then lo, hi");
    volatile LAS unsigned* MISC = (volatile LAS unsigned*)(lds + MISC_OFF);
    { PH_REGS for (int u = tid; u < (LDS_BYTES - LDSCTL_OFF) / 4; u += NWAVES * 64) ((LAS unsigned*)(lds + LDSCTL_OFF))[u] = 0u; }
    __syncthreads();
    XcdBarrier bar; bar.bar = (unsigned*)ctl + 4096; bar.x = 0; bar.st = nullptr;
    if (MK_ONE_LAUNCH) bar = xcd_barrier_post((unsigned*)ctl + 4096, MISC + 8, wave_s);
    const int lo = ((const __attribute__((address_space(4))) int*)kargs)[54], hi = ((const __attribute__((address_space(4))) int*)kargs)[55];
#define INP(p) (lo <= (p) && (p) < hi)
#define SEL(k) (SITE < 0 || SITE == (k))
#define SEAMG(p) do { if (MK_ONE_LAUNCH && (p) + 1 < hi) xcd_barrier(bar, wave_s); } while (0)
#define SEAM(p) do { if (MK_ONE_LAUNCH && (p) + 1 < hi) grp_barrier(bar, wave_s); } while (0)

#define PH_PTRS GAS unsigned char* ws = (GAS unsigned char*)KARG(26); bf16* W = (bf16*)(ws + WS_W); bf16* XB = (bf16*)(ws + WS_HN); float* RS = (float*)(ws + WS_RS); unsigned char* BIG = (unsigned char*)(ws + WS_BIG); \
    const int grp_ = opq_s(bx) & 7; unsigned char* BIGG = BIG + (size_t)grp_ * S_GRP; (void)BIGG; float* COS = (float*)(ws + WS_COS); float* SIN = (float*)(ws + WS_SIN); float* GATES = (float*)(ws + WS_GATES); bf16* KM = (bf16*)(ws + WS_KM); bf16* VMT = (bf16*)(ws + WS_VMT); GAS unsigned char* dob = (GAS unsigned char*)KARG(25); bf16* D0 = (bf16*)dob; bf16* YB = (bf16*)(dob + 64 * MiB); float* OUTF = (float*)dob;     \
    (void)W; (void)XB; (void)RS; (void)BIG; (void)COS; (void)SIN; (void)GATES; (void)KM; (void)VMT; (void)D0; (void)YB; (void)OUTF;
#define GROW(off_, pitch_) ((bf16*)(BIGG + (off_) - (size_t)grp_ * GTOK * (pitch_)))
#define GTOKB(off_) ((bf16*)(BIGG + (off_)) - (size_t)grp_ * GTOK)
#define RSB(i_) (RS + (size_t)((i_) & 3) * 4 * M)
#define KARG(k) ((const GAS void*)kargs[opq_s(k)])
#define INF(k) ((const float*)(const GAS float*)KARG(k))
    if constexpr (SEL(0)) if (INP(0)) { PH_REGS PH_PTRS const float* x_in = INF(0); const float* mem_in = INF(1); const int* pos_in = (const int*)(const GAS int*)KARG(2);
        LAS float* scr = (LAS float*)(lds + wave * 16384);
        int off = 0;
#define CVT_JOB(src_, K_, Nsrc_, Ndst_, kind_, dst_, gk_) do { const int nnb_ = (Ndst_) / 32, items_ = ((K_) / 64) * nnb_; \
        for (int it_ = (gw - off + 2 * NGW) % NGW; it_ < items_; it_ += NGW) { const int kb_ = it_ / nnb_, nb_ = it_ % nnb_; \
            cvt_item((src_), (K_), (Nsrc_), src_col((kind_), nb_ * 32), (dst_) + (size_t)(nb_ * 32) * (K_), scr, kb_, lane, (gk_)); } \
        off = (off + items_) % NGW; } while (0)
        for (int j = 0; j < 2; ++j) {
            bf16* wm = W + WE_MLA + j * WE_MLA_SZ;
            CVT_JOB(INF(3) + (size_t)j * D * MLA_IN, D, MLA_IN, MLA_INP, CK_MLA_IN, wm + WE_MLA_IN, INF(13) + (2 * j) * D);
            CVT_JOB(INF(5) + (size_t)j * QRANK * 1536, QRANK, 1536, 1536, CK_MLA_UQ, wm + WE_MLA_UQ, (const float*)nullptr);
            CVT_JOB(INF(7) + (size_t)j * KVRANK * 2048, KVRANK, 2048, 2048, CK_MLA_UKV, wm + WE_MLA_UKV, (const float*)nullptr);
            CVT_JOB(INF(8) + (size_t)j * D * D, D, D, D, CK_ID, wm + WE_MLA_O, (const float*)nullptr);
            bf16* wl = W + WE_L + j * WE_L_SZ;
            CVT_JOB(INF(9) + (size_t)j * D * MLSTM_IN, D, MLSTM_IN, 3584, CK_L_IN, wl + WE_L_IN, INF(13) + (2 * j + 1) * D);
            CVT_JOB(INF(12) + (size_t)j * D * D, D, D, D, CK_ID, wl + WE_L_O, (const float*)nullptr);
        }
        for (int l = 0; l < DEPTH; ++l) {
            bf16* wmm = W + WE_M + l * WE_M_SZ;
            CVT_JOB(INF(20) + (size_t)l * D * D, D, D, D, CK_ID, wmm + WE_M_Q, INF(15) + l * D);
            CVT_JOB(INF(21) + (size_t)l * D * 2048, D, 2048, 2048, CK_ID, wmm + WE_M_KV, (const float*)nullptr);
            CVT_JOB(INF(22) + (size_t)l * D * D, D, D, D, CK_ID, wmm + WE_M_O, (const float*)nullptr);
            bf16* wf = W + WE_F + l * WE_F_SZ;
            CVT_JOB(INF(23) + (size_t)l * D * 2 * DFF, D, 2 * DFF, 2 * DFF, CK_F_GU, wf + WE_F_GU, INF(18) + l * D);
            CVT_JOB(INF(24) + (size_t)l * DFF * D, DFF, D, D, CK_ID, wf + WE_F_D, (const float*)nullptr);
        }
#undef CVT_JOB
        for (int idx = bx * (NWAVES * 64) + tid; idx < M * 32; idx += G * NWAVES * 64) {
            const int tok = idx >> 5, i = idx & 31;
            double f = 1.0; for (int q = 0; q < i; ++q) f *= 0.7498942093324559;
            const double ang = (double)pos_in[tok] * f;
            const double kq = __builtin_rint(ang * 0.6366197723675814);
            const double r = (ang - kq * 1.5707963267948966) - kq * 6.123233995736766e-17;
            const double r2 = r * r;
            const double sn = r * (1.0 + r2 * (-1.0 / 6 + r2 * (1.0 / 120 + r2 * (-1.0 / 5040 + r2 * (1.0 / 362880 + r2 * (-1.0 / 39916800 + r2 * (1.0 / 6227020800.0)))))));
            const double cs = 1.0 + r2 * (-0.5 + r2 * (1.0 / 24 + r2 * (-1.0 / 720 + r2 * (1.0 / 40320 + r2 * (-1.0 / 3628800 + r2 * (1.0 / 479001600 + r2 * (-1.0 / 87178291200.0)))))));
            const int qd = (int)((long long)kq & 3);
            const double c = (qd == 0) ? cs : (qd == 1) ? -sn : (qd == 2) ? -cs : sn;
            const double s = (qd == 0) ? sn : (qd == 1) ? cs : (qd == 2) ? -sn : -cs;
            COS[idx] = (float)c; SIN[idx] = (float)s;
        }
        { const float* gkv = INF(16);
          for (int r = gw; r < MMEM; r += NGW) { f32x4 v[4]; load_row_f32(mem_in + (size_t)r * D, lane, v); const float rs = rsqrtf(row_ssq(v) * (1.f / D) + EPS);
            for (int l = 0; l < DEPTH; ++l) { f32x4 g[4], o[4]; load_row_f32(gkv + l * D, lane, g);
#pragma unroll
                for (int j = 0; j < 4; ++j) o[j] = v[j] * rs * g[j];
                bf16* dst = (bf16*)(BIG + (size_t)(r >> 9) * S_GRP + memn_slab_off(l)) + (size_t)(r & 511) * D;
                store_row_bf16(dst, lane, o); } } }
        for (int r0 = gw; r0 < M; r0 += 8 * NGW) { f32x4 v[8][4]; float ss[8];
#pragma unroll
            for (int k = 0; k < 8; ++k) load_row8_f32(x_in + (size_t)(r0 + k * NGW) * D, lane, v[k]);
#pragma unroll
            for (int k = 0; k < 8; ++k) { float a = 0.f;
#pragma unroll
                for (int j = 0; j < 4; ++j) a += (v[k][j][0] * v[k][j][0] + v[k][j][1] * v[k][j][1]) + (v[k][j][2] * v[k][j][2] + v[k][j][3] * v[k][j][3]);
                ss[k] = a; }
#pragma unroll
            for (int k = 0; k < 8; ++k) ss[k] = wave_sum(ss[k]);
#pragma unroll
            for (int k = 0; k < 8; ++k) { store_row8_bf16(XB + (size_t)(r0 + k * NGW) * D, lane, v[k]); if (lane < 4) RS[(size_t)lane * M + r0 + k * NGW] = lane == 0 ? ss[k] : 0.f; } }
        SEAMG(0);
    }
    if constexpr (SEL(1)) if (INP(1)) { PH_PTRS
        const int bxo = opq_s(bx); const int x = bxo & 7, j = bxo >> 3, l = 1 + 2 * (j >> 4), b = 2 * x + ((j >> 3) & 1), q = j & 3; const bool isk = ((j >> 2) & 1) == 0;
        const bf16* MEMN = (const bf16*)(BIG + (size_t)x * S_GRP + memn_slab_off(l)) - (size_t)x * 512 * D;     const bf16* wkv = W + WE_M + l * WE_M_SZ + WE_M_KV;
        if (G == 256) {
            pg8::Gemm g{isk ? MEMN : wkv + (size_t)D * D, isk ? wkv : MEMN, isk ? MMEM : D, isk ? D : MMEM, D}; pg8::OneOrder S; S.u0.pm = isk ? b : q; S.u0.pn = isk ? q : b; S.u0.w = 0;
            pg8::EpiPlain E{isk ? KM + (size_t)l * MMEM * D : VMT + (size_t)l * D * VMT_LD, isk ? (size_t)D : (size_t)VMT_LD, 1.f, nullptr};
            pg8::gemm_phase<pg8::EpiPlain, pg8::OneOrder, true, true>(lds, g, S, E, wave_s);
        }
        SEAM(1);
    }

#define UNPK8(w_, lo_, hi_) do { lo_ = (f32x4){bflo((w_).x), bfhi((w_).x), bflo((w_).y), bfhi((w_).y)}; hi_ = (f32x4){bflo((w_).z), bfhi((w_).z), bflo((w_).w), bfhi((w_).w)}; } while (0)
#define SSQ8(a_, b_) (((a_[0] * a_[0] + a_[1] * a_[1]) + (a_[2] * a_[2] + a_[3] * a_[3])) + ((b_[0] * b_[0] + b_[1] * b_[1]) + (b_[2] * b_[2] + b_[3] * b_[3])))
#define ROW_PASS8(rb_, Y_, gpost_, want_rs_, gates_, gb_, outf_, rso_) do { float* rso__ = (rso_); \
        const bf16* Y__ = (Y_); const float* gb__ = (gb_); float* outf__ = (outf_); const bool wrs__ = (want_rs_), gts__ = (gates_); \
        const LAS float* wgl = (const LAS float*)lds; \
        f32x4 gp__[4]; load_row8_f32((gpost_), lane, gp__); \
        u32x4 yw_[8][2], xw_[8][2]; float sy_[8], sx_[8]; \
          \
        _Pragma("unroll") for (int k_ = 0; k_ < 8; ++k_) { const size_t ro_ = (size_t)((rb_) + wave + 8 * k_) * D + 8 * lane; \
            _Pragma("unroll") for (int jj_ = 0; jj_ < 2; ++jj_) { const bf16* yp_ = Y__ + ro_ + 512 * jj_; asm volatile("global_load_dwordx4 %0, %1, off sc1" : "=v"(yw_[k_][jj_]) : "v"(yp_) : "memory"); \
                xw_[k_][jj_] = *(const u32x4*)(XB + ro_ + 512 * jj_); } } \
        asm volatile("s_waitcnt vmcnt(0)" : "+v"(yw_[0][0]), "+v"(yw_[0][1]), "+v"(yw_[1][0]), "+v"(yw_[1][1]), "+v"(yw_[2][0]), "+v"(yw_[2][1]), "+v"(yw_[3][0]), "+v"(yw_[3][1]), \
                                             "+v"(yw_[4][0]), "+v"(yw_[4][1]), "+v"(yw_[5][0]), "+v"(yw_[5][1]), "+v"(yw_[6][0]), "+v"(yw_[6][1]), "+v"(yw_[7][0]), "+v"(yw_[7][1]) :: "memory"); \
        _Pragma("unroll") for (int k_ = 0; k_ < 8; ++k_) { float s_ = 0.f; \
            _Pragma("unroll") for (int jj_ = 0; jj_ < 2; ++jj_) { f32x4 a_, b_; UNPK8(yw_[k_][jj_], a_, b_); s_ += SSQ8(a_, b_); } sy_[k_] = s_; } \
        _Pragma("unroll") for (int k_ = 0; k_ < 8; ++k_) sy_[k_] = wave_sum(sy_[k_]); \
        _Pragma("unroll") for (int k_ = 0; k_ < 8; ++k_) { const int r_ = (rb_) + wave + 8 * k_; const float rs_ = rsqrtf(sy_[k_] * (1.f / D) + EPS); float s_ = 0.f; f32x4 x_[4]; \
            asm volatile("" : "+v"(yw_[k_][0]), "+v"(yw_[k_][1]), "+v"(xw_[k_][0]), "+v"(xw_[k_][1]));     \
            _Pragma("unroll") for (int jj_ = 0; jj_ < 2; ++jj_) { f32x4 ya_, yb_, xa_, xb_; UNPK8(yw_[k_][jj_], ya_, yb_); UNPK8(xw_[k_][jj_], xa_, xb_); \
                x_[2 * jj_] = xa_ + ya_ * rs_ * gp__[2 * jj_]; x_[2 * jj_ + 1] = xb_ + yb_ * rs_ * gp__[2 * jj_ + 1]; s_ += SSQ8(x_[2 * jj_], x_[2 * jj_ + 1]); } \
            if (outf__) { _Pragma("unroll") for (int j_ = 0; j_ < 4; ++j_) *(f32x4*)(outf__ + (size_t)r_ * D + 8 * lane + 512 * (j_ >> 1) + 4 * (j_ & 1)) = x_[j_]; } \
            else store_row8_bf16(XB + (size_t)r_ * D, lane, x_); \
            sx_[k_] = s_; \
            if (gts__) { float ga_[8]; \
                _Pragma("unroll") for (int g_ = 0; g_ < 8; ++g_) { float a_ = 0.f; \
                    _Pragma("unroll") for (int j_ = 0; j_ < 4; ++j_) { const f32x4 w_ = *(const LAS f32x4*)(wgl + g_ * D + 8 * lane + 512 * (j_ >> 1) + 4 * (j_ & 1)); a_ += (x_[j_][0] * w_[0] + x_[j_][1] * w_[1]) + (x_[j_][2] * w_[2] + x_[j_][3] * w_[3]); } \
                    ga_[g_] = a_; } \
                const float st_ = wave_sum(s_); \
                _Pragma("unroll") for (int g_ = 0; g_ < 8; ++g_) ga_[g_] = wave_sum(ga_[g_]); \
                const float r2_ = rsqrtf(st_ * (1.f / D) + EPS); float out_ = 0.f; \
                _Pragma("unroll") for (int g_ = 0; g_ < 8; ++g_) if (lane == g_) out_ = ga_[g_] * r2_ + gb__[g_]; \
                if (lane < 4) rso__[(size_t)lane * M + r_] = lane == 0 ? st_ : 0.f; if (lane < 8) GATES[(size_t)r_ * 8 + lane] = out_; } } \
        if (wrs__ && !gts__) { \
            _Pragma("unroll") for (int k_ = 0; k_ < 8; ++k_) sx_[k_] = wave_sum(sx_[k_]); \
            _Pragma("unroll") for (int k_ = 0; k_ < 8; ++k_) if (lane < 4) rso__[(size_t)lane * M + (rb_) + wave + 8 * k_] = lane == 0 ? sx_[k_] : 0.f; } } while (0)
#define FUSED_TAIL(sidx_, S_, Y_, gpost_, gpre_, gw_src_, gb_, outf_) do { PH_REGS \
        gu32* tk_ = (gu32*)((GAS unsigned char*)KARG(26) + WS_CTL) + 32768 + (size_t)(sidx_) * (128 * 16); pg8::Unit u_ = {0, 0, 0};     \
        if (tid == 0) { if (MISC[10] == 0u) __builtin_amdgcn_fence(__ATOMIC_RELEASE, "agent");     \
            asm volatile("s_waitcnt vmcnt(0)" ::: "memory"); \
            for (int i_ = 0; (S_).next(i_, u_); ++i_) (void)__hip_atomic_fetch_add(tk_ + u_.pm * 16, 1u, __ATOMIC_RELAXED, __HIP_MEMORY_SCOPE_AGENT); } \
        const float* gws__ = (gw_src_); const float* gpre__ = (gpre_); \
        if (gws__) { LAS float* wst_ = (LAS float*)lds;     \
            for (int i_ = tid; i_ < 8 * D; i_ += NWAVES * 64) { const int k_ = i_ >> 3, g_ = i_ & 7; wst_[g_ * D + k_] = gws__[(size_t)k_ * MLSTM_IN + 3072 + g_] * gpre__[k_]; } } \
        for (int i_ = 0; (S_).next(i_, u_); ++i_) { \
            if (tid == 0) { unsigned sp_ = 0; while (__hip_atomic_load(tk_ + u_.pm * 16, __ATOMIC_RELAXED, __HIP_MEMORY_SCOPE_AGENT) < 4u && ++sp_ < (1u << 22)) __builtin_amdgcn_s_sleep(1); \
                if (MISC[10] == 0u) { __builtin_amdgcn_fence(__ATOMIC_ACQUIRE, "agent"); asm volatile("s_waitcnt vmcnt(0)" ::: "memory"); } }     \
            __syncthreads(); \
            const int rb__ = u_.pm * 256 + u_.pn * 64; \
            ROW_PASS8(rb__, Y_, gpost_, gpre__ != nullptr, gws__ != nullptr, gb_, outf_, RSB((sidx_) + 1)); } \
        if (gws__) __syncthreads(); } while (0)

#define LN_EPI(sidx_, gpost_) pg8::EpiLN E{XB, (gpost_), RSB((sidx_) + 1), (float*)(ws + WS_EX), (unsigned*)(ws + WS_CTL) + 32768 + (size_t)(sidx_) * (128 * 16), (LAS float*)(lds + RING_BYTES + 1024), MISC[10], (float*)nullptr}
    for (int l = 0; l < DEPTH; ++l) {
        const int base = 2 + l * NPH_L, j = l >> 1;
        if ((l & 1) == 0) {
#define MLA_PTRS PH_PTRS const bf16* wm = W + WE_MLA + j * WE_MLA_SZ; bf16* PROJ = GROW(B_QN, MLA_INP * 2); bf16* QN = GROW(B_QN, 2048); bf16* QR = GROW(B_QR, 1024); bf16* VT = GTOKB(B_VT); \
            bf16* CQN = GROW(B_CQN, QRANK * 2); bf16* CKVN = GROW(B_CKVN, KVRANK * 2); bf16* KR = GROW(B_KR, 128); bf16* KN = D0; \
            (void)wm; (void)PROJ; (void)QN; (void)QR; (void)VT; (void)CQN; (void)CKVN; (void)KR; (void)KN;
            if constexpr (SEL(2)) if (INP(base + 0)) { MLA_PTRS
                {
                {
                const bf16* MEMN = (const bf16*)(BIGG + memn_slab_off(l)) - (size_t)grp_ * 512 * D;     const bf16* wkv = W + WE_M + l * WE_M_SZ + WE_M_KV;
                pg8::Gemm g{XB, wm + WE_MLA_IN, M, MLA_INP, D}; pg8::TriOrder S; S.s0.init(M, MLA_INP, G, opq_s(bx)); const bf16* wv = wkv + (size_t)D * D;
                S.dA1 = (const char*)MEMN - (const char*)XB; S.dB1 = (const char*)wkv - (const char*)(wm + WE_MLA_IN); S.dA2 = (const char*)wv - (const char*)XB; S.dB2 = (const char*)MEMN - (const char*)(wm + WE_MLA_IN);
                pg8::EpiTri E{PROJ, (size_t)MLA_INP, RSB(3 * l), (KM + (size_t)l * MMEM * D) - PROJ, (long)D - (long)MLA_INP, (VMT + (size_t)l * D * VMT_LD) - PROJ, (long)VMT_LD - (long)MLA_INP};
                pg8::gemm_phase<pg8::EpiTri, pg8::TriOrder, true, true>(lds, g, S, E, wave_s);
                }
                }
                SEAM(base + 0);
            }
            if constexpr (SEL(3)) if (INP(base + 1)) { PH_REGS MLA_PTRS
                const float* gq = INF(4) + j * QRANK; const float* gkv = INF(6) + j * KVRANK;
                const int bxo = opq_s(bx), vcu = (G % 8 == 0) ? (bxo % 8) * (G / 8) + bxo / 8 : bxo; const int rpw = M / NGW;
                float gq6[6];
#pragma unroll
                for (int jj = 0; jj < 3; ++jj) { gq6[2 * jj] = gq[2 * lane + 128 * jj]; gq6[2 * jj + 1] = gq[2 * lane + 128 * jj + 1]; }
                const f32x4 g4 = *(const f32x4*)(gkv + 4 * lane);
                for (int r0 = (vcu * NWAVES + wave) * rpw; r0 < (vcu * NWAVES + wave + 1) * rpw; r0 += 8) {
                    unsigned cw[8][3]; u32x2 wk[8]; bf16 krw[8]; float cs[8], sn[8];
#pragma unroll
                    for (int k = 0; k < 8; ++k) { const bf16* p = PROJ + (size_t)(r0 + k) * MLA_INP;
#pragma unroll
                        for (int jj = 0; jj < 3; ++jj) cw[k][jj] = *(const unsigned*)(p + 2 * lane + 128 * jj);
                        wk[k] = *(const u32x2*)(p + QRANK + 4 * lane); krw[k] = p[QRANK + KVRANK + lane];
                        cs[k] = COS[(size_t)(r0 + k) * 32 + (lane & 31)]; sn[k] = SIN[(size_t)(r0 + k) * 32 + (lane & 31)]; }
#pragma unroll
                    for (int k = 0; k < 8; ++k) { const int r = r0 + k;
                        float cq[6]; float s1 = 0.f;
#pragma unroll
                        for (int jj = 0; jj < 3; ++jj) { cq[2 * jj] = bflo(cw[k][jj]); cq[2 * jj + 1] = bfhi(cw[k][jj]); s1 += cq[2 * jj] * cq[2 * jj] + cq[2 * jj + 1] * cq[2 * jj + 1]; }
                        const f32x4 ck = (f32x4){bflo(wk[k].x), bfhi(wk[k].x), bflo(wk[k].y), bfhi(wk[k].y)};
                        float s2 = (ck[0] * ck[0] + ck[1] * ck[1]) + (ck[2] * ck[2] + ck[3] * ck[3]);
                        const float kr = bf2f(krw[k]);
                        s1 = wave_sum(s1); s2 = wave_sum(s2);
                        const float r1 = rsqrtf(s1 * (1.f / QRANK) + EPS), r2 = rsqrtf(s2 * (1.f / KVRANK) + EPS);
#pragma unroll
                        for (int jj = 0; jj < 3; ++jj) *(unsigned*)(CQN + (size_t)r * QRANK + 2 * lane + 128 * jj) = pg8::cvt_pk_bf16(cq[2 * jj] * r1 * gq6[2 * jj], cq[2 * jj + 1] * r1 * gq6[2 * jj + 1]);
                        { u32x2 w; w.x = pg8::cvt_pk_bf16(ck[0] * r2 * g4[0], ck[1] * r2 * g4[1]); w.y = pg8::cvt_pk_bf16(ck[2] * r2 * g4[2], ck[3] * r2 * g4[3]);
                          *(u32x2*)(CKVN + (size_t)r * KVRANK + 4 * lane) = w; }
                        { float other; { auto rr = __builtin_amdgcn_permlane32_swap(__float_as_uint(kr), __float_as_uint(kr), false, false); other = (lane < 32) ? __uint_as_float(rr[1]) : __uint_as_float(rr[0]); }
                          const float o = (lane < 32) ? (kr * cs[k] - other * sn[k]) : (kr * cs[k] + other * sn[k]);
                          KR[(size_t)r * 64 + lane] = (bf16)(pg8::cvt_pk_bf16(o, 0.f) & 0xffffu); }
                    }
                }
                SEAM(base + 1);
            }
            if constexpr (SEL(4)) if (INP(base + 2)) { MLA_PTRS
                {
                { pg8::Gemm g{CQN, wm + WE_MLA_UQ, M, 1536, QRANK}; pg8::StaticOrder S; S.init(M, 1536, G, opq_s(bx)); pg8::EpiSplit E{QN, (size_t)1024, 4, QR, (size_t)512, MLA_QS};
                  pg8::gemm_phase<pg8::EpiSplit, pg8::StaticOrder, true, true>(lds, g, S, E, wave_s); }
                { pg8::Gemm g{CKVN, wm + WE_MLA_UKV, M, D, KVRANK}; pg8::StaticOrder S; S.init(M, D, G, opq_s(bx)); pg8::EpiPlain E{KN, (size_t)D, 1.f, nullptr};
                  pg8::gemm_phase<pg8::EpiPlain, pg8::StaticOrder, true, true>(lds, g, S, E, wave_s); }
                { pg8::Gemm g{wm + WE_MLA_UKV + (size_t)D * KVRANK, CKVN, D, M, KVRANK}; pg8::StaticOrder S; S.init(D, M, G, opq_s(bx)); pg8::EpiPlain E{VT, (size_t)VT_LD, 1.f, nullptr};
                  pg8::gemm_phase<pg8::EpiPlain, pg8::StaticOrder, true, true>(lds, g, S, E, wave_s); }
                }
                SEAM(base + 2);
            }
            if constexpr (SEL(5)) if (INP(base + 3)) { PH_REGS MLA_PTRS
                const int bxo = opq_s(bx), vcu = (G % 8 == 0) ? (bxo % 8) * (G / 8) + bxo / 8 : bxo;
                for (int p = vcu; p < NB * MLA_H * 4; p += G) { const int v_ = p % G, rnd = p / G, x = v_ & 3, h = (v_ >> 2) & 7, b = (G == 256) ? 2 * (v_ >> 5) + rnd : (p >> 5);
                    mla_attn_unit(b, h, 7 - x, QN, QR, KN, KR, VT, COS, SIN, QN, lds, tid);
                    mla_attn_unit(b, h, x, QN, QR, KN, KR, VT, COS, SIN, QN, lds, tid); }
                SEAM(base + 3);
            }
            if constexpr (SEL(6)) if (INP(base + 4)) { MLA_PTRS
                pg8::Gemm g{QN, wm + WE_MLA_O, M, D, D}; pg8::StaticOrder S; S.init(M, D, G, opq_s(bx)); LN_EPI(l * 3 + 0, INF(14) + l * D);
                pg8::gemm_phase<pg8::EpiLN, pg8::StaticOrder, true, true>(lds, g, S, E, wave_s);
                SEAM(base + 5);
            }
        } else {
#define L_PTRS PH_PTRS const bf16* wl = W + WE_L + j * WE_L_SZ; bf16* QK = GROW(B_QK, 2048); bf16* OG = GROW(B_OG, 2048); bf16* KVT = GTOKB(B_KVT); bf16* HS = D0; bf16* GA = GROW(B_QK, 2048); \
            (void)wl; (void)QK; (void)OG; (void)KVT; (void)HS; (void)GA;
            if constexpr (SEL(7)) if (INP(base + 0)) { L_PTRS
                {
                {
                { pg8::Gemm g{XB, wl + WE_L_IN, M, 2048, D}; pg8::StaticOrder S; S.init(M, 2048, G, opq_s(bx)); pg8::EpiQKO E{QK, OG, LQ_S, RSB(3 * l)};
                  pg8::gemm_phase<pg8::EpiQKO, pg8::StaticOrder, true, true>(lds, g, S, E, wave_s); }
                { pg8::Gemm g{wl + WE_L_IN + (size_t)2560 * D, XB, 1024, M, D}; pg8::StaticOrder S; S.init(1024, M, G, opq_s(bx)); pg8::EpiPlainT<2> E{KVT, (size_t)KVT_LD, 1.f, RSB(3 * l)};
                  pg8::gemm_phase<pg8::EpiPlainT<2>, pg8::StaticOrder, true, true>(lds, g, S, E, wave_s); }
                }
                }
                SEAM(base + 0);
            }
            if constexpr (SEL(8)) if (INP(base + 1)) { PH_REGS L_PTRS
                { const int bxo = opq_s(bx), vcu = (G % 8 == 0) ? (bxo % 8) * (G / 8) + bxo / 8 : bxo;
                  for (int u = vcu; u < NB * LH * 4; u += G) mlstm_scan_unit(u, QK, KVT, GATES, HS, lds, tid); }
                SEAM(base + 1);
            }
            if constexpr (SEL(9)) if (INP(base + 2)) { PH_REGS L_PTRS
                const float* hn = INF(11) + j * LH * LDV;
                const int bxo = opq_s(bx), vcu = (G % 8 == 0) ? (bxo % 8) * (G / 8) + bxo / 8 : bxo; const int rpw = M / NGW;
                f32x4 gh[4]; load_row8_f32(hn, lane, gh);
                for (int r0 = (vcu * NWAVES + wave) * rpw; r0 < (vcu * NWAVES + wave + 1) * rpw; r0 += 8) {
                    u32x4 hw[8][2], ow[8][2];
#pragma unroll
                    for (int k = 0; k < 8; ++k)
#pragma unroll
                        for (int jj = 0; jj < 2; ++jj) { hw[k][jj] = *(const u32x4*)(HS + (size_t)(r0 + k) * D + 8 * lane + 512 * jj); ow[k][jj] = *(const u32x4*)(OG + (size_t)(r0 + k) * D + 8 * lane + 512 * jj); }
#pragma unroll
                    for (int k = 0; k < 8; ++k)
#pragma unroll
                        for (int jj = 0; jj < 2; ++jj) { const u32x4 h = hw[k][jj], o = ow[k][jj];
                            const f32x4 h0 = (f32x4){bflo(h.x), bfhi(h.x), bflo(h.y), bfhi(h.y)}, h1 = (f32x4){bflo(h.z), bfhi(h.z), bflo(h.w), bfhi(h.w)};
                            const f32x4 o0 = (f32x4){bflo(o.x), bfhi(o.x), bflo(o.y), bfhi(o.y)}, o1 = (f32x4){bflo(o.z), bfhi(o.z), bflo(o.w), bfhi(o.w)};
                            float ss = ((h0[0] * h0[0] + h0[1] * h0[1]) + (h0[2] * h0[2] + h0[3] * h0[3])) + ((h1[0] * h1[0] + h1[1] * h1[1]) + (h1[2] * h1[2] + h1[3] * h1[3]));
                            ss = half_sum(ss);
                            const float rs = rsqrtf(ss * (1.f / LDV) + EPS);
                            const f32x4 a0 = h0 * rs * gh[2 * jj] * o0, a1 = h1 * rs * gh[2 * jj + 1] * o1;
                            u32x4 w; w.x = pg8::cvt_pk_bf16(a0[0], a0[1]); w.y = pg8::cvt_pk_bf16(a0[2], a0[3]); w.z = pg8::cvt_pk_bf16(a1[0], a1[1]); w.w = pg8::cvt_pk_bf16(a1[2], a1[3]);
                            *(u32x4*)(GA + (size_t)(r0 + k) * D + 8 * lane + 512 * jj) = w; }
                }
                SEAM(base + 2);
            }
            if constexpr (SEL(10)) if (INP(base + 4)) { L_PTRS
                pg8::Gemm g{GA, wl + WE_L_O, M, D, D}; pg8::StaticOrder S; S.init(M, D, G, opq_s(bx)); LN_EPI(l * 3 + 0, INF(14) + l * D);
                pg8::gemm_phase<pg8::EpiLN, pg8::StaticOrder, true, true>(lds, g, S, E, wave_s);
                SEAM(base + 5);
            }
        }
        {
#define MEM_PTRS PH_PTRS const bf16* wmm = W + WE_M + l * WE_M_SZ; bf16* QM = GROW(B_QM, 2048); (void)wmm; (void)QM;
            if constexpr (SEL(12)) if (INP(base + 6)) { MEM_PTRS
                {
                pg8::Gemm g{XB, wmm + WE_M_Q, M, D, D}; pg8::StaticOrder S; S.init(M, D, G, opq_s(bx)); pg8::EpiPlainT<1> E{QM, (size_t)D, MEM_QS, RSB(3 * l + 1)};
                pg8::gemm_phase<pg8::EpiPlainT<1>, pg8::StaticOrder, true, true>(lds, g, S, E, wave_s);
                }
                SEAM(base + 6);
            }
            if constexpr (SEL(13)) if (INP(base + 7)) { PH_REGS MEM_PTRS
                const bf16* km = KM + (size_t)l * MMEM * D; const bf16* vmt = VMT + (size_t)l * D * VMT_LD;
                const int bxo = opq_s(bx), vcu = (G % 8 == 0) ? (bxo % 8) * (G / 8) + bxo / 8 : bxo;
                for (int u = vcu; u < (M / 256) * 4; u += G) { const int v_ = u % G, rnd = u / G, pmi = v_ & 7, h = (v_ >> 3) & 3, b = (G == 256) ? 2 * (v_ >> 5) + rnd : (u >> 5);
                    mem_attn_unit(b * 8 + pmi, h, QM, km, vmt, QM, lds, tid); }
                SEAM(base + 7);
            }
            if constexpr (SEL(14)) if (INP(base + 8)) { MEM_PTRS
                pg8::Gemm g{QM, wmm + WE_M_O, M, D, D}; pg8::StaticOrder S; S.init(M, D, G, opq_s(bx)); LN_EPI(l * 3 + 1, INF(17) + l * D);
                pg8::gemm_phase<pg8::EpiLN, pg8::StaticOrder, true, true>(lds, g, S, E, wave_s);
                SEAM(base + 9);
            }
        }
        {
#define FFN_PTRS PH_PTRS const bf16* wf = W + WE_F + l * WE_F_SZ; bf16* HID = GROW(B_HID, DFF * 2); (void)wf; (void)HID;
            if constexpr (SEL(16)) if (INP(base + 10)) { FFN_PTRS
                {
                pg8::Gemm g{XB, wf + WE_F_GU, M, 2 * DFF, D}; pg8::StaticOrder S; S.init(M, 2 * DFF, G, opq_s(bx)); pg8::EpiSwiGLU E{HID, (size_t)DFF, RSB(3 * l + 2)};
                pg8::gemm_phase<pg8::EpiSwiGLU, pg8::StaticOrder, true, true>(lds, g, S, E, wave_s);
                }
                if (l + 1 < DEPTH) SEAM(base + 10); else SEAMG(base + 10);
            }
            if constexpr (SEL(17)) if (INP(base + 11)) { FFN_PTRS
                bf16* YF = (l + 1 < DEPTH) ? YB : (bf16*)KM;
                pg8::Gemm g{HID, wf + WE_F_D, M, D, DFF}; pg8::StaticOrder S; S.init(M, D, G, opq_s(bx));
                if (l == 1 || l + 1 == DEPTH) {
                    pg8::EpiLN E{XB, INF(19) + l * D, RSB((l * 3 + 2) + 1), (float*)(ws + WS_EX), (unsigned*)(ws + WS_CTL) + 32768 + (size_t)(l * 3 + 2) * (128 * 16), (LAS float*)(lds + RING_BYTES + 1024), MISC[10], (l + 1 == DEPTH) ? OUTF : (float*)nullptr};
                    pg8::gemm_phase<pg8::EpiLN, pg8::StaticOrder, true, true>(lds, g, S, E, wave_s);
                } else {
                pg8::EpiPlain E{YF, (size_t)D, 1.f, nullptr};
                pg8::gemm_phase<pg8::EpiPlain, pg8::StaticOrder, true, true>(lds, g, S, E, wave_s);
                { const bool nxt_l = (l + 1 < DEPTH) && ((l + 1) & 1);
                  FUSED_TAIL(l * 3 + 2, S, YF, INF(19) + l * D, (l + 1 < DEPTH) ? INF(13) + (l + 1) * D : (const float*)nullptr,
                             nxt_l ? INF(9) + (size_t)j * D * MLSTM_IN : (const float*)nullptr, nxt_l ? INF(10) + j * 8 : (const float*)nullptr, (l + 1 < DEPTH) ? (float*)nullptr : OUTF); }
                }
                SEAM(base + 12);
            }
        }
    }
}

template <int S> static void launch_site(const Args& a, hipStream_t stream) {
    static bool attr = false;
    if (!attr) { attr = true; if (hipFuncSetAttribute((const void*)fwd<S>, hipFuncAttributeMaxDynamicSharedMemorySize, LDS_BYTES) != hipSuccess) fprintf(stderr, "kernel_launch: hipFuncSetAttribute failed (site %d)\n", S); }
    hipLaunchKernelGGL(fwd<S>, dim3(256), dim3(NWAVES * 64), LDS_BYTES, stream, a);
}
extern "C" void kernel_launch(void* const* d_in, const int* in_sizes, int n_in, void* d_out, int out_size, void* d_ws, size_t ws_size, hipStream_t stream) {
    if (n_in != 25 || out_size != M * D || ws_size < WS_END) { fprintf(stderr, "kernel_launch: unexpected shapes (n_in %d out %d ws %zu)\n", n_in, out_size, ws_size); return; }
    (void)hipMemsetAsync((char*)d_ws + WS_CTL, 0, CTL_ZERO_BYTES, stream);
    Args a{};
    for (int i = 0; i < 25; ++i) a.in[i] = d_in[i];
    a.out = (float*)d_out; a.ws = (unsigned char*)d_ws;
#if MK_ONE_LAUNCH
    a.lo = 0; a.hi = NPHASES;
    launch_site<-1>(a, stream);
#else
    for (int p = 0; p < NPHASES; ++p) {
        a.lo = p; a.hi = p + 1;
        if (p == 0) { launch_site<0>(a, stream); continue; }
        if (p == 1) { launch_site<1>(a, stream); continue; }
        const int k = (p - 2) % NPH_L, l = (p - 2) / NPH_L; const bool mla = (l & 1) == 0;
        switch (k) {
        case 0: if (mla) launch_site<2>(a, stream); else launch_site<7>(a, stream); break;
        case 1: if (mla) launch_site<3>(a, stream); else launch_site<8>(a, stream); break;
        case 2: if (mla) launch_site<4>(a, stream); else launch_site<9>(a, stream); break;
        case 3: if (mla) launch_site<5>(a, stream); break;
        case 4: if (mla) launch_site<6>(a, stream); else launch_site<10>(a, stream); break;
        case 5: launch_site<11>(a, stream); break;
        case 6: launch_site<12>(a, stream); break;
        case 7: launch_site<13>(a, stream); break;
        case 8: launch_site<14>(a, stream); break;
        case 9: launch_site<15>(a, stream); break;
        case 10: launch_site<16>(a, stream); break;
        case 11: launch_site<17>(a, stream); break;
        default: launch_site<18>(a, stream); break;
        }
    }
#endif
}
```
